# Optimizing an MI355X kernel written in HIP

```python
import math
import jax, jax.numpy as jnp
from jax import lax
import numpy as np

D_MODEL = 1024
BATCH = 8
SEQ = 4096
DEPTH = 2

N_MEM = 256
RET_HEADS = 4
RET_DK = D_MODEL // RET_HEADS
RET_DV = 2 * RET_DK
RET_CHUNK = 128
DIFF_HEADS = 4
DIFF_DK = D_MODEL // (2 * DIFF_HEADS)
DIFF_DV = 2 * DIFF_DK
Q_BLOCK = 128
CROSS_HEADS = 4
CROSS_DH = D_MODEL // CROSS_HEADS
D_FF = 4 * D_MODEL
N_BRANCH = 3
EPS = 1e-6

RET_QK_W = RET_HEADS * RET_DK
RET_V_W = RET_HEADS * RET_DV
DIFF_QK_W = DIFF_HEADS * 2 * DIFF_DK
DIFF_V_W = DIFF_HEADS * DIFF_DV
CROSS_W = CROSS_HEADS * CROSS_DH
GATE_W = N_BRANCH * D_MODEL
SPLITS = (RET_QK_W, RET_QK_W, RET_V_W, RET_V_W, DIFF_QK_W, DIFF_QK_W, DIFF_V_W, CROSS_W, GATE_W)
D_IN = RET_QK_W * 2 + RET_V_W * 2 + DIFF_QK_W * 2 + DIFF_V_W + CROSS_W + GATE_W

kernel_name = "hybrid_retention_diffattn_gated_block"


def rms_norm(x, g):
    xf = x.astype(jnp.float32)
    y = xf * lax.rsqrt(jnp.mean(xf * xf, axis=-1, keepdims=True) + EPS)
    return (y * g.astype(jnp.float32)).astype(x.dtype)


def head_norm(x, g, center):
    b, s, h, d = x.shape
    xf = x.astype(jnp.float32)
    if center:
        xf = xf - jnp.mean(xf, axis=-1, keepdims=True)
    y = xf * lax.rsqrt(jnp.mean(xf * xf, axis=-1, keepdims=True) + EPS)
    return (y.reshape(b, s, h * d) * g.astype(jnp.float32)).astype(x.dtype)


def split_cols(z, widths):
    out = []
    off = 0
    for w in widths:
        out.append(z[..., off:off + w])
        off += w
    return out


def retention_chunkwise(q, k, v):
    b, s, h, dk = q.shape
    dv = v.shape[-1]
    c = RET_CHUNK
    n = s // c
    log_g = jnp.log(1.0 - jnp.exp2(-5.0 - jnp.arange(h, dtype=jnp.float32)))
    idx = jnp.arange(c, dtype=jnp.float32)
    rel = idx[:, None] - idx[None, :]
    intra = jnp.where(rel >= 0, jnp.exp(log_g[:, None, None] * jnp.maximum(rel, 0.0)), 0.0)
    in_decay = jnp.exp(log_g[:, None] * (idx + 1.0))
    st_decay = jnp.exp(log_g[:, None] * (c - 1.0 - idx))
    ch_decay = jnp.exp(log_g * c)

    def to_chunks(t):
        return t.reshape(b, n, c, h, t.shape[-1]).transpose(1, 0, 3, 2, 4)

    qc = to_chunks(q)
    kc = to_chunks(k * (dk ** -0.5))
    vc = to_chunks(v)

    def step(state, inp):
        qi, ki, vi = inp
        scores = jnp.einsum("bhid,bhjd->bhij", qi, ki) * intra[None]
        inner = jnp.einsum("bhij,bhje->bhie", scores, vi)
        cross = jnp.einsum("bhid,bhde->bhie", qi, state) * in_decay[None, :, :, None]
        new_state = ch_decay[None, :, None, None] * state + jnp.einsum(
            "bhjd,bhje->bhde", ki * st_decay[None, :, :, None], vi)
        return new_state, inner + cross

    state0 = jnp.zeros((b, h, dk, dv), jnp.float32)
    _, out = lax.scan(step, state0, (qc, kc, vc))
    return out.transpose(1, 0, 3, 2, 4).reshape(b, s, h, dv).astype(q.dtype)


def diff_attention(q, k, v, lam):
    b, s, h, _, d = q.shape
    qt = q.transpose(0, 2, 3, 1, 4)
    kt = k.transpose(0, 2, 3, 1, 4)
    vt = v.transpose(0, 2, 1, 3)
    slopes = jnp.exp2(-8.0 * (jnp.arange(h, dtype=jnp.float32) + 1.0) / h)
    scale = d ** -0.5
    outs = []
    for i in range(s // Q_BLOCK):
        q0 = i * Q_BLOCK
        kend = q0 + Q_BLOCK
        sc = jnp.einsum("bhmqd,bhmkd->bhmqk", qt[:, :, :, q0:kend], kt[:, :, :, :kend]).astype(jnp.float32) * scale
        dist = (jnp.arange(q0, kend)[:, None] - jnp.arange(kend)[None, :]).astype(jnp.float32)
        sc = sc - (slopes[:, None, None] * dist[None])[None, :, None]
        sc = jnp.where(dist[None, None, None] >= 0, sc, -jnp.inf)
        p = jax.nn.softmax(sc, axis=-1)
        pd = p[:, :, 0] - lam * p[:, :, 1]
        outs.append(jnp.einsum("bhqk,bhke->bhqe", pd, vt[:, :, :kend]))
    o = jnp.concatenate(outs, axis=2)
    return o.transpose(0, 2, 1, 3).astype(q.dtype)


def memory_cross_attention(q, mk, mv):
    sc = jnp.einsum("bshd,bmhd->bhsm", q, mk).astype(jnp.float32) * (q.shape[-1] ** -0.5)
    p = jax.nn.softmax(sc, axis=-1)
    return jnp.einsum("bhsm,bmhd->bshd", p, mv).astype(q.dtype)


def setup_inputs(seed: int = 0) -> dict:
    key = jax.random.key(seed)
    ks = jax.random.split(key, 20)
    f32 = jnp.float32
    res_scale = (2.0 * DEPTH) ** -0.5

    def nrm(k, shape, scale):
        return jax.random.normal(k, shape, f32) * scale

    def gain(k, shape):
        return 1.0 + 0.02 * jax.random.normal(k, shape, f32)

    return {
        "x": nrm(ks[0], (BATCH, SEQ, D_MODEL), 1.0),
        "mem": nrm(ks[1], (BATCH, N_MEM, D_MODEL), 1.0),
        "g_mix": gain(ks[2], (DEPTH, D_MODEL)),
        "w_in": nrm(ks[3], (DEPTH, D_MODEL, D_IN), D_MODEL ** -0.5),
        "g_ret": gain(ks[4], (DEPTH, RET_V_W)),
        "w_ret_o": nrm(ks[5], (DEPTH, RET_V_W, D_MODEL), RET_V_W ** -0.5),
        "lambda_q1": nrm(ks[6], (DEPTH, DIFF_DK), 0.1),
        "lambda_k1": nrm(ks[7], (DEPTH, DIFF_DK), 0.1),
        "lambda_q2": nrm(ks[8], (DEPTH, DIFF_DK), 0.1),
        "lambda_k2": nrm(ks[9], (DEPTH, DIFF_DK), 0.1),
        "g_diff": gain(ks[10], (DEPTH, DIFF_V_W)),
        "w_diff_o": nrm(ks[11], (DEPTH, DIFF_V_W, D_MODEL), DIFF_V_W ** -0.5),
        "g_mem": gain(ks[12], (DEPTH, D_MODEL)),
        "w_mem_kv": nrm(ks[13], (DEPTH, D_MODEL, 2 * CROSS_W), D_MODEL ** -0.5),
        "w_cross_o": nrm(ks[14], (DEPTH, CROSS_W, D_MODEL), CROSS_W ** -0.5),
        "w_out": nrm(ks[15], (DEPTH, D_MODEL, D_MODEL), D_MODEL ** -0.5 * res_scale),
        "g_ffn": gain(ks[16], (DEPTH, D_MODEL)),
        "w_up": nrm(ks[17], (DEPTH, D_MODEL, D_FF), D_MODEL ** -0.5),
        "w_down": nrm(ks[18], (DEPTH, D_FF, D_MODEL), D_FF ** -0.5 * res_scale),
        "g_final": gain(ks[19], (D_MODEL,)),
    }


def reference(x, mem, g_mix, w_in, g_ret, w_ret_o, lambda_q1, lambda_k1, lambda_q2, lambda_k2,
              g_diff, w_diff_o, g_mem, w_mem_kv, w_cross_o, w_out, g_ffn, w_up, w_down, g_final):
    b, s, _ = x.shape
    m = mem.shape[1]
    for l in range(DEPTH):
        h = rms_norm(x, g_mix[l])
        z = h @ w_in[l]
        rq, rk, rv, rg, dq, dk, dv, cq, gates = split_cols(z, SPLITS)

        ret = retention_chunkwise(rq.reshape(b, s, RET_HEADS, RET_DK),
                                  rk.reshape(b, s, RET_HEADS, RET_DK),
                                  rv.reshape(b, s, RET_HEADS, RET_DV))
        ret = jax.nn.swish(rg) * head_norm(ret, g_ret[l], True)
        y_ret = ret @ w_ret_o[l]

        lam_init = 0.8 - 0.6 * math.exp(-0.3 * l)
        lam = (jnp.exp(jnp.sum(lambda_q1[l].astype(jnp.float32) * lambda_k1[l].astype(jnp.float32)))
               - jnp.exp(jnp.sum(lambda_q2[l].astype(jnp.float32) * lambda_k2[l].astype(jnp.float32)))
               + lam_init)
        da = diff_attention(dq.reshape(b, s, DIFF_HEADS, 2, DIFF_DK),
                            dk.reshape(b, s, DIFF_HEADS, 2, DIFF_DK),
                            dv.reshape(b, s, DIFF_HEADS, DIFF_DV), lam)
        da = head_norm(da, g_diff[l], False) * (1.0 - lam_init)
        y_diff = da @ w_diff_o[l]

        kv = rms_norm(mem, g_mem[l]) @ w_mem_kv[l]
        mk = kv[..., :CROSS_W].reshape(b, m, CROSS_HEADS, CROSS_DH)
        mv = kv[..., CROSS_W:].reshape(b, m, CROSS_HEADS, CROSS_DH)
        ca = memory_cross_attention(cq.reshape(b, s, CROSS_HEADS, CROSS_DH), mk, mv)
        y_cross = ca.reshape(b, s, CROSS_W) @ w_cross_o[l]

        g = jax.nn.sigmoid(gates.astype(jnp.float32)).astype(x.dtype).reshape(b, s, N_BRANCH, D_MODEL)
        merged = g[:, :, 0] * y_ret + g[:, :, 1] * y_diff + g[:, :, 2] * y_cross
        x = x + merged @ w_out[l]

        u = jax.nn.relu(rms_norm(x, g_ffn[l]) @ w_up[l])
        x = x + (u * u) @ w_down[l]
    return rms_norm(x, g_final)
```

```cpp
#include <hip/hip_runtime.h>
#include <cstdio>
#include <cstdint>

#ifndef MK_PER_PHASE
#define MK_PER_PHASE 0
#endif

constexpr int BATCH = 8, SEQ = 4096, DM = 1024, DEPTH = 2, NMEM = 256;
constexpr int MALL = BATCH * SEQ;
constexpr int GB = 4, MG = GB * SEQ, NGRP = BATCH / GB;
constexpr int DIN = 13312, NSEQ = 7168, NLOC = 6144, DFF = 4096;
constexpr int MEMROWS = BATCH * NMEM;
constexpr float EPS = 1e-6f;
constexpr int NWAVES = 8;

#define GAS __attribute__((address_space(1)))
#define LAS __attribute__((address_space(3)))
typedef unsigned short bf16;
typedef unsigned v4u __attribute__((ext_vector_type(4)));
typedef unsigned v2u __attribute__((ext_vector_type(2)));
typedef float f32x4 __attribute__((ext_vector_type(4)));
typedef float f32x16 __attribute__((ext_vector_type(16)));
typedef short bf16x8 __attribute__((ext_vector_type(8)));
typedef short s16x4 __attribute__((ext_vector_type(4)));
typedef GAS unsigned gu32;
typedef GAS unsigned long long gu64;
#define RLX_AGENT __ATOMIC_RELAXED, __HIP_MEMORY_SCOPE_AGENT
#define LDS_WAIT() asm volatile("s_waitcnt lgkmcnt(0)" ::: "memory")
#define VM_WAIT() asm volatile("s_waitcnt vmcnt(0)" ::: "memory")
typedef float f32x2_t __attribute__((ext_vector_type(2)));
typedef __bf16 bf16x2_t __attribute__((ext_vector_type(2)));
__device__ __forceinline__ unsigned cvtpk(float lo, float hi) { const f32x2_t v = {lo, hi}; const bf16x2_t b = __builtin_convertvector(v, bf16x2_t); return __builtin_bit_cast(unsigned, b); }
__device__ __forceinline__ float bflo(unsigned u) { return __builtin_bit_cast(float, u << 16); }
__device__ __forceinline__ float bfhi(unsigned u) { return __builtin_bit_cast(float, u & 0xffff0000u); }
__device__ __forceinline__ float wave_sum(float v) {
#pragma unroll
    for (int o = 1; o < 64; o <<= 1) v += __shfl_xor(v, o);
    return v;
}
__device__ __forceinline__ float fast_sigmoid(float x) { return __builtin_amdgcn_rcpf(1.0f + __builtin_amdgcn_exp2f(-1.4426950408889634f * x)); }

namespace pg8 {
#define PG8_LAS __attribute__((address_space(3)))
typedef unsigned short bf16_t;
typedef short bf16x8 __attribute__((ext_vector_type(8)));
typedef float f32x4 __attribute__((ext_vector_type(4)));
typedef unsigned u32x4 __attribute__((ext_vector_type(4)));
typedef unsigned u32x2 __attribute__((ext_vector_type(2)));
constexpr int BM = 256, BK = 64, HALF = 128, HTB = HALF * BK * 2  , STAGE_BYTES = 8 * HTB, NXCD = 8, WGM = 8;

__host__ __device__ __forceinline__ int lds_byte(int r, int c) { const int st = (r >> 4) * 2 + (c >> 5), rr = r & 15, cc = c & 31, ob = rr * 64 + cc * 2; return st * 1024 + (ob ^ (((ob >> 9) & 1) << 5)); }
__host__ __device__ __forceinline__ void stage_rc(int b, int& R, int& C) { const int st = b / 1024, sb = b % 1024, swz = sb ^ (((sb >> 9) & 1) << 5); R = (st >> 1) * 16 + swz / 64; C = (st & 1) * 32 + (swz % 64) / 2; }
__host__ __device__ __forceinline__ int perm32(int rho) { const int n = rho >> 4, i = rho & 15; return 8 * (i >> 2) + 4 * n + (i & 3); }

struct Unit { int pm, pn; };
struct Gemm { const bf16_t* A; const bf16_t* Bt; int K, lda, ldb, bsh; long a_pm, a_pn, b_pm, b_pn;
    __device__ __forceinline__ const char* a_ptr(const Unit& u) const { return (const char*)(A + (size_t)u.pm * a_pm + (size_t)u.pn * a_pn); }
    __device__ __forceinline__ const char* b_ptr(const Unit& u) const { return (const char*)(Bt + (size_t)(u.pm >> bsh) * b_pm + (size_t)u.pn * b_pn); }
};
__device__ __forceinline__ Gemm gemm_plain(const bf16_t* A, const bf16_t* Bt, int K) { Gemm g; g.A = A; g.Bt = Bt; g.K = K; g.lda = K; g.ldb = K; g.bsh = 0; g.a_pm = 256L * K; g.a_pn = 0; g.b_pm = 0; g.b_pn = 256L * K; return g; }

struct StaticOrder {
    int nM, nN, nwg, G, c;
    __host__ __device__ void init(int M, int N, int G_, int c_) { nM = M / BM; nN = N / BM; nwg = nM * nN; G = G_; c = c_; }
    __host__ __device__ bool next(int i, Unit& u) const {
        const long L = (long)i * G + c; if (L >= nwg) return false;
        int wgid = (int)L; { const int q = nwg / NXCD, r = nwg % NXCD, xcd = wgid % NXCD, off = wgid / NXCD; wgid = (xcd < r ? xcd * (q + 1) : r * (q + 1) + (xcd - r) * q) + off; }
        const int nig = WGM * nN, gid = wgid / nig, fm = gid * WGM, gsz = (nM - fm) < WGM ? (nM - fm) : WGM;
        u.pm = fm + ((wgid % nig) % gsz); u.pn = (wgid % nig) / gsz; return true;
    }
    __device__ __forceinline__ void a_ready(const Unit&) const {}
    __device__ __forceinline__ void done(const Unit&) const {}
};
__device__ __forceinline__ unsigned cvt_pk_bf16(float lo, float hi) { return ::cvtpk(lo, hi); }
__device__ __forceinline__ u32x4 pack8(f32x4 v0, f32x4 v1) { u32x4 w; w.x = cvt_pk_bf16(v0[0], v0[1]); w.y = cvt_pk_bf16(v0[2], v0[3]); w.z = cvt_pk_bf16(v1[0], v1[1]); w.w = cvt_pk_bf16(v1[2], v1[3]); return w; }

#define UNR _Pragma("unroll")
#ifndef ZERO_BR
#define ZERO_BR 0
#endif
#define DBG_SC(br) ((((ZERO_BR) >> (br)) & 1) ? 0.0f : 1.0f)
__device__ __forceinline__ f32x4 bf4(u32x2 g) { f32x4 r; r[0] = __builtin_bit_cast(float, g.x << 16); r[1] = __builtin_bit_cast(float, g.x & 0xffff0000u); r[2] = __builtin_bit_cast(float, g.y << 16); r[3] = __builtin_bit_cast(float, g.y & 0xffff0000u); return r; }

template <int ACT> struct EpiBf16 {
    static constexpr bool PERM = true, AFTER_DRAIN = false;
    bf16_t* O; int ldc;
    __device__ __forceinline__ void operator()(const f32x4 (&acc)[2][2][4][2], const Unit& u, int wr, int wc, int fr, int fq) const {
        const int col0 = u.pn * BM + wc * 32 + 8 * fq;
        UNR for (int ai = 0; ai < 2; ++ai) UNR for (int m = 0; m < 4; ++m) {
            const int row = u.pm * BM + ai * HALF + wr * 64 + m * 16 + fr; bf16_t* rowp = O + (size_t)row * ldc + col0;
            UNR for (int bj = 0; bj < 2; ++bj) { f32x4 v0 = acc[ai][bj][m][0], v1 = acc[ai][bj][m][1];
                if (ACT == 1) { UNR for (int j = 0; j < 4; ++j) { const float a = fmaxf(v0[j], 0.f), b = fmaxf(v1[j], 0.f); v0[j] = a * a; v1[j] = b * b; } }
                *(u32x4*)(rowp + bj * HALF) = pack8(v0, v1); } }
    }
};
struct EpiZseq {
    static constexpr bool PERM = true, AFTER_DRAIN = false;
    bf16_t *RQ, *RK, *RV, *DQ, *DK, *DV;
    __device__ __forceinline__ void operator()(const f32x4 (&acc)[2][2][4][2], const Unit& u, int wr, int wc, int fr, int fq) const {
        const int pn = u.pn, cw = wc * 32 + 8 * fq;
        UNR for (int ai = 0; ai < 2; ++ai) UNR for (int m = 0; m < 4; ++m) {
            const int row = u.pm * BM + ai * HALF + wr * 64 + m * 16 + fr; const int b = row >> 12, s = row & 4095;
            UNR for (int bj = 0; bj < 2; ++bj) { f32x4 v0 = acc[ai][bj][m][0], v1 = acc[ai][bj][m][1]; const int c = bj * HALF + cw;
                bf16_t* dst;
                if (pn < 4)       dst = RQ + ((size_t)(b * 4 + pn) * SEQ + s) * 256 + c;
                else if (pn < 8)  { dst = RK + ((size_t)(b * 4 + (pn - 4)) * SEQ + s) * 256 + c; v0 = v0 * 0.0625f; v1 = v1 * 0.0625f; }
                else if (pn < 16) { const int hh = (pn - 8) >> 1, ce = ((pn - 8) & 1) * 256 + c; dst = RV + ((size_t)((b * 4 + hh) * 8 + (ce >> 6)) * SEQ + s) * 64 + (ce & 63); }
                else if (pn < 20) dst = DQ + ((size_t)((b * 4 + (pn - 16)) * 2 + bj) * SEQ + s) * 128 + cw;
                else if (pn < 24) dst = DK + ((size_t)((b * 4 + (pn - 20)) * 2 + bj) * SEQ + s) * 128 + cw;
                else              dst = DV + ((size_t)((b * 4 + (pn - 24)) * 2 + bj) * SEQ + s) * 128 + cw;
                *(u32x4*)dst = pack8(v0, v1); } }
    }
};
struct EpiZloc {
    static constexpr bool PERM = true, AFTER_DRAIN = false;
    bf16_t *SRG, *CQ, *GATES;
    __device__ __forceinline__ void operator()(const f32x4 (&acc)[2][2][4][2], const Unit& u, int wr, int wc, int fr, int fq) const {
        const int pn = u.pn, cw = wc * 32 + 8 * fq;
        UNR for (int ai = 0; ai < 2; ++ai) UNR for (int m = 0; m < 4; ++m) {
            const int row = u.pm * BM + ai * HALF + wr * 64 + m * 16 + fr;
            UNR for (int bj = 0; bj < 2; ++bj) { f32x4 v0 = acc[ai][bj][m][0], v1 = acc[ai][bj][m][1]; const int c = bj * HALF + cw;
                bf16_t* dst;
                if (pn >= 8 && pn < 12) dst = CQ + ((size_t)(pn - 8) * MG + row) * 256 + c;
                else {
                    UNR for (int j = 0; j < 4; ++j) { const float s0 = fast_sigmoid(v0[j]), s1 = fast_sigmoid(v1[j]); v0[j] = (pn < 8) ? v0[j] * s0 : s0; v1[j] = (pn < 8) ? v1[j] * s1 : s1; }
                    dst = (pn < 8) ? SRG + (size_t)row * 2048 + pn * 256 + c : GATES + (size_t)row * 3072 + (pn - 12) * 256 + c; }
                *(u32x4*)dst = pack8(v0, v1); } }
    }
};
struct EpiSoftmax {
    static constexpr bool PERM = true, AFTER_DRAIN = true;
    bf16_t* P;
    __device__ __forceinline__ void operator()(const f32x4 (&)[2][2][4][2], const Unit&, int, int, int, int) const {}
    __device__ __forceinline__ void fused(f32x4 (&acc)[2][2][4][2], const Unit& u, int wr, int wc, int fr, int fq, PG8_LAS unsigned char* lds, int, int) const {
        PG8_LAS float* T0 = (PG8_LAS float*)lds;
        PG8_LAS float* T1 = (PG8_LAS float*)(lds + 4096);
        constexpr float C2 = 0.0625f * 1.4426950408889634f;
        UNR for (int ai = 0; ai < 2; ++ai) UNR for (int m = 0; m < 4; ++m) { float v = -3.0e38f;
            UNR for (int bj = 0; bj < 2; ++bj) UNR for (int n = 0; n < 2; ++n) { const f32x4 x = acc[ai][bj][m][n]; v = fmaxf(v, fmaxf(fmaxf(x[0], x[1]), fmaxf(x[2], x[3]))); }
            v = fmaxf(v, __shfl_xor(v, 16)); v = fmaxf(v, __shfl_xor(v, 32));
            if (fq == 0) T0[(ai * HALF + wr * 64 + m * 16 + fr) * 4 + wc] = v; }
        asm volatile("s_waitcnt lgkmcnt(0)" ::: "memory"); __builtin_amdgcn_s_barrier(); asm volatile("" ::: "memory");
        UNR for (int ai = 0; ai < 2; ++ai) UNR for (int m = 0; m < 4; ++m) { const int R = ai * HALF + wr * 64 + m * 16 + fr; const f32x4 t = *(const PG8_LAS f32x4*)(T0 + R * 4);
            const float g = fmaxf(fmaxf(t[0], t[1]), fmaxf(t[2], t[3])) * C2; float s = 0.f;
            UNR for (int bj = 0; bj < 2; ++bj) UNR for (int n = 0; n < 2; ++n) { f32x4 x = acc[ai][bj][m][n];
                UNR for (int j = 0; j < 4; ++j) { x[j] = __builtin_amdgcn_exp2f(fmaf(x[j], C2, -g)); s += x[j]; }
                acc[ai][bj][m][n] = x; }
            s += __shfl_xor(s, 16); s += __shfl_xor(s, 32);
            if (fq == 0) T1[R * 4 + wc] = s; }
        asm volatile("s_waitcnt lgkmcnt(0)" ::: "memory"); __builtin_amdgcn_s_barrier(); asm volatile("" ::: "memory");
        const int col0 = wc * 32 + 8 * fq;
        UNR for (int ai = 0; ai < 2; ++ai) UNR for (int m = 0; m < 4; ++m) { const int R = ai * HALF + wr * 64 + m * 16 + fr; const f32x4 t = *(const PG8_LAS f32x4*)(T1 + R * 4);
            const float iv = 1.0f / ((t[0] + t[1]) + (t[2] + t[3]));
            bf16_t* rowp = P + ((size_t)u.pn * MG + (size_t)u.pm * BM + R) * 256 + col0;
            UNR for (int bj = 0; bj < 2; ++bj) *(u32x4*)(rowp + bj * HALF) = pack8(acc[ai][bj][m][0] * iv, acc[ai][bj][m][1] * iv); }
    }
};
template <bool FIRST> struct EpiGateF32 {
    static constexpr bool PERM = false, AFTER_DRAIN = false;
    float* MF; const bf16_t* G; int br;
    __device__ __forceinline__ void operator()(const f32x4 (&acc)[2][2][4][2], const Unit& u, int wr, int wc, int fr, int fq) const {
        const int col0 = u.pn * BM + wc * 32 + 4 * fq;
        UNR for (int ai = 0; ai < 2; ++ai) UNR for (int m = 0; m < 4; ++m) {
            const int row = u.pm * BM + ai * HALF + wr * 64 + m * 16 + fr; float* rowp = MF + (size_t)row * 1024 + col0; const bf16_t* gp = G + (size_t)row * 3072 + br * 1024 + col0;
            UNR for (int bj = 0; bj < 2; ++bj) UNR for (int n = 0; n < 2; ++n) { const f32x4 g4 = bf4(*(const u32x2*)(gp + bj * HALF + n * 16));
                f32x4 o = acc[ai][bj][m][n] * g4 * DBG_SC(br); if (!FIRST) o = o + *(const f32x4*)(rowp + bj * HALF + n * 16);
                *(f32x4*)(rowp + bj * HALF + n * 16) = o; } }
    }
};
struct EpiGateOut {
    static constexpr bool PERM = true, AFTER_DRAIN = false;
    const float* MF; bf16_t* MB; const bf16_t* G; int br;
    __device__ __forceinline__ void operator()(const f32x4 (&acc)[2][2][4][2], const Unit& u, int wr, int wc, int fr, int fq) const {
        const int col0 = u.pn * BM + wc * 32 + 8 * fq;
        UNR for (int ai = 0; ai < 2; ++ai) UNR for (int m = 0; m < 4; ++m) {
            const int row = u.pm * BM + ai * HALF + wr * 64 + m * 16 + fr; const float* mp = MF + (size_t)row * 1024 + col0; const bf16_t* gp = G + (size_t)row * 3072 + br * 1024 + col0; bf16_t* op = MB + (size_t)row * 1024 + col0;
            UNR for (int bj = 0; bj < 2; ++bj) { const u32x4 gv = *(const u32x4*)(gp + bj * HALF);
                const f32x4 g0 = bf4((u32x2){gv.x, gv.y}), g1 = bf4((u32x2){gv.z, gv.w});
                const f32x4 o0 = acc[ai][bj][m][0] * g0 * DBG_SC(br) + *(const f32x4*)(mp + bj * HALF), o1 = acc[ai][bj][m][1] * g1 * DBG_SC(br) + *(const f32x4*)(mp + bj * HALF + 4);
                *(u32x4*)(op + bj * HALF) = pack8(o0, o1); } }
    }
};
struct EpiRes {
    static constexpr bool PERM = false, AFTER_DRAIN = false;
    const float* BASE; float* OUT;
    __device__ __forceinline__ void operator()(const f32x4 (&acc)[2][2][4][2], const Unit& u, int wr, int wc, int fr, int fq) const {
        const int col0 = u.pn * BM + wc * 32 + 4 * fq;
        UNR for (int ai = 0; ai < 2; ++ai) UNR for (int m = 0; m < 4; ++m) {
            const int row = u.pm * BM + ai * HALF + wr * 64 + m * 16 + fr; const float* bp = BASE + (size_t)row * 1024 + col0; float* op = OUT + (size_t)row * 1024 + col0;
            UNR for (int bj = 0; bj < 2; ++bj) UNR for (int n = 0; n < 2; ++n) *(f32x4*)(op + bj * HALF + n * 16) = acc[ai][bj][m][n] + *(const f32x4*)(bp + bj * HALF + n * 16); }
    }
};

template <class Epi, class Sched, bool ALIGN_EPI = false, bool SP2 = false>
__device__ __forceinline__ void gemm_phase(PG8_LAS unsigned char* lds, const Gemm g, const Sched& S, const Epi& E) {
    int tid_ = threadIdx.x; asm volatile("" : "+v"(tid_));
    const int tid = tid_, wid = __builtin_amdgcn_readfirstlane(tid >> 6), lane = tid & 63, wr = wid >> 2, wc = wid & 3, fr = lane & 15, fq = lane >> 4;
    const int K = g.K, nt = K / BK;
    unsigned voffA[2], voffB[2];
#pragma unroll
    for (int i = 0; i < 2; ++i) { int R, C; stage_rc(tid * 16 + i * 8192, R, C); const int Rb = Epi::PERM ? ((R & ~31) + perm32(R & 31)) : R;
        voffA[i] = (unsigned)(R * g.lda + C) * 2u; voffB[i] = (unsigned)(Rb * g.ldb + C) * 2u; }
    const size_t kstep = (size_t)(BK * 2);
    const size_t hstepA = (size_t)HALF * g.lda * 2, hstepB = (size_t)HALF * g.ldb * 2;
    const unsigned ldsw = (unsigned)wid * 1024u;
    const int aoff = lds_byte(wr * 64 + fr, fq * 8), boff = lds_byte(wc * 32 + fr, fq * 8);
#define PG8_SA(b, h) (((b) * 2 + (h)) * HTB)
#define PG8_SB(b, h) ((4 + (b) * 2 + (h)) * HTB)
#define PG8_STAGE(bufoff, gbase, voff) do { _Pragma("unroll") for (int _i = 0; _i < 2; ++_i) \
        __builtin_amdgcn_global_load_lds((const unsigned*)((const char*)(gbase) + (voff)[_i]), (PG8_LAS unsigned*)(lds + (bufoff) + ldsw + _i * 8192), 16, 0, 0); } while (0)
#define PG8_LDA(dst, b, h) do { _Pragma("unroll") for (int m = 0; m < 4; ++m) _Pragma("unroll") for (int k = 0; k < 2; ++k) dst[m][k] = *(const PG8_LAS bf16x8*)(lds + PG8_SA(b, h) + aoff + m * 2048 + k * 1024); } while (0)
#define PG8_LDB(dst, b, h) do { _Pragma("unroll") for (int n = 0; n < 2; ++n) _Pragma("unroll") for (int k = 0; k < 2; ++k) dst[n][k] = *(const PG8_LAS bf16x8*)(lds + PG8_SB(b, h) + boff + n * 2048 + k * 1024); } while (0)
#define PG8_MMA(ai, bj, At, Bt) do { __builtin_amdgcn_s_setprio(1); _Pragma("unroll") for (int m = 0; m < 4; ++m) _Pragma("unroll") for (int n = 0; n < 2; ++n) _Pragma("unroll") for (int k = 0; k < 2; ++k) \
        acc[ai][bj][m][n] = __builtin_amdgcn_mfma_f32_16x16x32_bf16(Bt[n][k], At[m][k], acc[ai][bj][m][n], 0, 0, 0); __builtin_amdgcn_s_setprio(0); } while (0)
#define PG8_WAIT_V(n) asm volatile("s_waitcnt vmcnt(" #n ")" ::: "memory")
#define PG8_WAIT_L(n) asm volatile("s_waitcnt lgkmcnt(" #n ")" ::: "memory")
#define PG8_BAR __builtin_amdgcn_s_barrier()
#define PG8_SCHED __builtin_amdgcn_sched_barrier(0)
    Unit cur, nxt; int ui = 0;
    if (!S.next(0, cur)) return;
    f32x4 acc[2][2][4][2];
#pragma unroll
    for (int a = 0; a < 2; ++a)
#pragma unroll
        for (int b = 0; b < 2; ++b)
#pragma unroll
            for (int m = 0; m < 4; ++m)
#pragma unroll
                for (int n = 0; n < 2; ++n) acc[a][b][m][n] = (f32x4){0.f, 0.f, 0.f, 0.f};
    bf16x8 At[4][2], B0[2][2], B1[2][2];
    const char* cA = g.a_ptr(cur); const char* cB = g.b_ptr(cur);
    S.a_ready(cur);
    if constexpr (SP2) {
        PG8_STAGE(PG8_SB(0, 0), cB, voffB); PG8_STAGE(PG8_SB(0, 1), cB + hstepB, voffB); PG8_STAGE(PG8_SA(0, 0), cA, voffA); PG8_STAGE(PG8_SA(0, 1), cA + hstepA, voffA);
        if (wr == 1) PG8_BAR;
        PG8_WAIT_V(2); PG8_BAR;
        PG8_STAGE(PG8_SB(1, 0), cB + kstep, voffB); PG8_STAGE(PG8_SA(1, 0), cA + kstep, voffA); PG8_STAGE(PG8_SB(1, 1), cB + hstepB + kstep, voffB);
        PG8_WAIT_V(6); PG8_BAR;
    } else {
        PG8_STAGE(PG8_SB(0, 0), cB, voffB); PG8_STAGE(PG8_SA(0, 0), cA, voffA); PG8_STAGE(PG8_SB(0, 1), cB + hstepB, voffB); PG8_STAGE(PG8_SA(0, 1), cA + hstepA, voffA);
        if (wr == 1) PG8_BAR;
        PG8_WAIT_V(4); PG8_BAR;
        PG8_STAGE(PG8_SB(1, 0), cB + kstep, voffB); PG8_STAGE(PG8_SA(1, 0), cA + kstep, voffA); PG8_STAGE(PG8_SB(1, 1), cB + hstepB + kstep, voffB);
        PG8_WAIT_V(6); PG8_BAR;
    }
    for (;;) {
        const bool has_next = S.next(ui + 1, nxt);
        const char* nA = has_next ? g.a_ptr(nxt) : cA; const char* nB = has_next ? g.b_ptr(nxt) : cB;
        for (int t = 0; t < nt; t += 2) {
            const bool last = (t == nt - 2);
            const char* a1 = cA + (size_t)(t + 1) * kstep;
            const char* a2 = last ? nA : cA + (size_t)(t + 2) * kstep; const char* b2 = last ? nB : cB + (size_t)(t + 2) * kstep;
            const char* a3 = a2 + kstep; const char* b3 = b2 + kstep;
            if (last && has_next) S.a_ready(nxt);
            if constexpr (SP2) {
            PG8_LDB(B0, 0, 0); PG8_LDB(B1, 0, 1); PG8_SCHED; PG8_LDA(At, 0, 0); PG8_STAGE(PG8_SA(1, 1), a1 + hstepA, voffA);
            PG8_WAIT_V(8); PG8_WAIT_L(0); PG8_BAR; PG8_MMA(0, 0, At, B0); PG8_MMA(0, 1, At, B1); PG8_BAR; PG8_SCHED;
            PG8_LDA(At, 0, 1); PG8_STAGE(PG8_SB(0, 0), b2, voffB); PG8_STAGE(PG8_SB(0, 1), b2 + hstepB, voffB); PG8_STAGE(PG8_SA(0, 0), a2, voffA);
            PG8_WAIT_V(8); PG8_WAIT_L(0); PG8_BAR; PG8_MMA(1, 0, At, B0); PG8_MMA(1, 1, At, B1); PG8_BAR; PG8_SCHED;
            PG8_LDB(B0, 1, 0); PG8_LDB(B1, 1, 1); PG8_SCHED; PG8_LDA(At, 1, 0); PG8_STAGE(PG8_SA(0, 1), a2 + hstepA, voffA);
            PG8_WAIT_V(8); PG8_WAIT_L(0); PG8_BAR; PG8_MMA(0, 0, At, B0); PG8_MMA(0, 1, At, B1); PG8_BAR; PG8_SCHED;
            PG8_LDA(At, 1, 1); PG8_STAGE(PG8_SB(1, 0), b3, voffB); PG8_STAGE(PG8_SB(1, 1), b3 + hstepB, voffB); PG8_STAGE(PG8_SA(1, 0), a3, voffA);
            PG8_WAIT_V(8); PG8_WAIT_L(0); PG8_BAR; PG8_MMA(1, 0, At, B0); PG8_MMA(1, 1, At, B1); PG8_BAR; PG8_SCHED;
            } else {
            PG8_LDB(B0, 0, 0); PG8_SCHED; PG8_LDA(At, 0, 0); PG8_STAGE(PG8_SA(1, 1), a1 + hstepA, voffA);
            PG8_WAIT_L(8); PG8_BAR; PG8_WAIT_L(0); PG8_MMA(0, 0, At, B0); PG8_BAR; PG8_SCHED;
            PG8_LDB(B1, 0, 1); PG8_STAGE(PG8_SB(0, 0), b2, voffB);
            PG8_BAR; PG8_WAIT_L(0); PG8_MMA(0, 1, At, B1); PG8_BAR;
            PG8_LDA(At, 0, 1); PG8_STAGE(PG8_SA(0, 0), a2, voffA);
            PG8_BAR; PG8_WAIT_L(0); PG8_MMA(1, 0, At, B0); PG8_BAR; PG8_SCHED;
            PG8_STAGE(PG8_SB(0, 1), b2 + hstepB, voffB);
            PG8_WAIT_V(6); PG8_BAR; PG8_MMA(1, 1, At, B1); PG8_BAR;
            PG8_LDB(B0, 1, 0); PG8_SCHED; PG8_LDA(At, 1, 0); PG8_STAGE(PG8_SA(0, 1), a2 + hstepA, voffA);
            PG8_WAIT_L(8); PG8_BAR; PG8_WAIT_L(0); PG8_MMA(0, 0, At, B0); PG8_BAR; PG8_SCHED;
            PG8_LDB(B1, 1, 1); PG8_STAGE(PG8_SB(1, 0), b3, voffB);
            PG8_BAR; PG8_WAIT_L(0); PG8_MMA(0, 1, At, B1); PG8_BAR;
            PG8_LDA(At, 1, 1); PG8_STAGE(PG8_SA(1, 0), a3, voffA);
            PG8_BAR; PG8_WAIT_L(0); PG8_MMA(1, 0, At, B0); PG8_BAR; PG8_SCHED;
            PG8_STAGE(PG8_SB(1, 1), b3 + hstepB, voffB);
            PG8_WAIT_V(6); PG8_BAR; PG8_MMA(1, 1, At, B1); PG8_BAR;
            }
        }
        if constexpr (ALIGN_EPI) { if (wr == 0) PG8_BAR; }
        if constexpr (!Epi::AFTER_DRAIN) { E(acc, cur, wr, wc, fr, fq); S.done(cur); }
        if (!has_next) break;
#pragma unroll
        for (int a = 0; a < 2; ++a)
#pragma unroll
            for (int b = 0; b < 2; ++b)
#pragma unroll
                for (int m = 0; m < 4; ++m)
#pragma unroll
                    for (int n = 0; n < 2; ++n) acc[a][b][m][n] = (f32x4){0.f, 0.f, 0.f, 0.f};
        cur = nxt; cA = nA; cB = nB; ++ui;
        if constexpr (ALIGN_EPI) { if (wr == 1) PG8_BAR; }
    }
    PG8_WAIT_V(0);
    if constexpr (!ALIGN_EPI) { if (wr == 0) PG8_BAR; }
    PG8_BAR;
    if constexpr (Epi::AFTER_DRAIN) { E.fused(acc, cur, wr, wc, fr, fq, lds, wid, lane); S.done(cur); }
#undef PG8_SA
#undef PG8_SB
#undef PG8_STAGE
#undef PG8_LDA
#undef PG8_LDB
#undef PG8_MMA
#undef PG8_WAIT_V
#undef PG8_WAIT_L
#undef PG8_BAR
#undef PG8_SCHED
}
}


namespace da {
constexpr int D = 128; constexpr float THR = 8.f; constexpr bool WSKIP = false;
constexpr bool SPLIT_KV = true;
constexpr float SCALE = 0.08838834764831845f;
constexpr int NW = 8, QBLK = 32, KVBLK = 64, QB = NW * QBLK;
constexpr int SHM_V = KVBLK * D * 2, SHM_K = KVBLK * D * 2;
constexpr int LDS_BYTES = 2 * SHM_V + 2 * SHM_K + NW * 64 * 4;


typedef short bf16x8 __attribute__((ext_vector_type(8)));
typedef short s16x4 __attribute__((ext_vector_type(4)));
typedef float f32x16 __attribute__((ext_vector_type(16)));
typedef float f32x4 __attribute__((ext_vector_type(4)));
typedef unsigned u32x4 __attribute__((ext_vector_type(4)));
template <class A, class Bt> struct same_t { static constexpr bool v = false; };
template <class A> struct same_t<A, A> { static constexpr bool v = true; };

#define KSWZ(row, colB) ((row) * 256 + ((colB) ^ (((row) & 7) << 4)))
#define SBAR() __builtin_amdgcn_sched_barrier(0)
__device__ __forceinline__ int v_st(int k, int c) { const int kk = (k & ~0xC) | ((k & 4) << 1) | ((k & 8) >> 1); return ((kk >> 3) * 4 + (c >> 5)) * 512 + ((kk & 7) * 32 + (c & 31)) * 2; }
__device__ __forceinline__ int v_rd_base(int lane) { return ((lane & 3) << 3) | (((lane >> 2) & 3) << 6) | (((lane >> 4) & 1) << 5) | (((lane >> 5) & 1) << 8); }
constexpr int v_rd_off(int d0, int ks, int half) { return d0 * 512 + ks * 4096 + half * 2048; }
__device__ __forceinline__ int crow(int r, int hi) { return (r & 3) + 8 * (r >> 2) + 4 * hi; }
__device__ __forceinline__ unsigned cvtpk(float lo, float hi) {
    unsigned r; asm volatile("v_cvt_pk_bf16_f32 %0, %1, %2" : "=v"(r) : "v"(lo), "v"(hi)); return r;
}
__device__ __forceinline__ bf16x8 pack8(f32x4 a, f32x4 b) {
    u32x4 w = {cvtpk(a[0], a[1]), cvtpk(a[2], a[3]), cvtpk(b[0], b[1]), cvtpk(b[2], b[3])};
    return *reinterpret_cast<bf16x8*>(&w);
}
template <class T> __device__ __forceinline__ bf16x8 load8(const T* p) {
    if constexpr (same_t<T, float>::v) { return pack8(*(const f32x4*)p, *(const f32x4*)(p + 4)); }
    else { return *reinterpret_cast<const bf16x8*>(p); }
}
__device__ __forceinline__ void alibi_add(f32x16& p0, f32x16& p1, float bsl, int krel, int hi) {
    const float b8_ = bsl * 8.f, b32_ = bsl * 32.f; float b = bsl * (float)(krel + 4 * hi);
#pragma unroll
    for (int g = 0; g < 4; ++g) { float c = b;
#pragma unroll
        for (int k = 0; k < 4; ++k) { p0[4 * g + k] += c; p1[4 * g + k] += c + b32_; c += bsl; }
        b += b8_; }
}
__device__ __forceinline__ void mask_tile(f32x16& p0, f32x16& p1, int dq, unsigned W) {
    const float NEG = -__builtin_inff();
#pragma unroll
    for (int r = 0; r < 16; ++r) {
        const int c = (r & 3) + 8 * (r >> 2);
        if ((unsigned)(dq - c) >= W) p0[r] = NEG;
        if ((unsigned)(dq - c - 32) >= W) p1[r] = NEG;
    }
}
__device__ __forceinline__ void partialSM(f32x16& p0, f32x16& p1, float& m_reg, float& mn, float& alpha) {
    float pmax = p0[0]; for (int r = 1; r < 16; ++r) pmax = fmaxf(pmax, p0[r]); for (int r = 0; r < 16; ++r) pmax = fmaxf(pmax, p1[r]);
    { auto rr = __builtin_amdgcn_permlane32_swap(__float_as_uint(pmax), __float_as_uint(pmax), false, false);
      pmax = fmaxf(__uint_as_float(rr[0]), __uint_as_float(rr[1])); }
    constexpr float C2 = 1.4426950408889634f * SCALE;
    if (__builtin_expect(__all((pmax - m_reg) * SCALE <= THR), 1)) { mn = m_reg; alpha = 1.f; }
    else { mn = fmaxf(m_reg, pmax); alpha = __builtin_amdgcn_exp2f((m_reg - mn) * C2); m_reg = mn; }
    const float mnL = -mn * C2;
    for (int r = 0; r < 16; ++r) p0[r] = fmaf(p0[r], C2, mnL); for (int r = 0; r < 16; ++r) p1[r] = fmaf(p1[r], C2, mnL);
    for (int r = 0; r < 16; ++r) p0[r] = __builtin_amdgcn_exp2f(p0[r]);
}
__device__ __forceinline__ void finishSM(f32x16& p0, f32x16& p1, float alpha, float& l_reg, bf16x8& pa0, bf16x8& pa1, bf16x8& pa2, bf16x8& pa3) {
    for (int r = 0; r < 16; ++r) p1[r] = __builtin_amdgcn_exp2f(p1[r]);
    float ps = 0; for (int r = 0; r < 16; ++r) ps += p0[r]; for (int r = 0; r < 16; ++r) ps += p1[r];
    { auto rr = __builtin_amdgcn_permlane32_swap(__float_as_uint(ps), __float_as_uint(ps), false, false);
      ps = __uint_as_float(rr[0]) + __uint_as_float(rr[1]); }
    l_reg = l_reg * alpha + ps;
#define PK4(P, B_, OUT) do { unsigned a0 = cvtpk(P[B_+0], P[B_+1]), a1 = cvtpk(P[B_+2], P[B_+3]);                          \
        unsigned b0 = cvtpk(P[B_+4], P[B_+5]), b1 = cvtpk(P[B_+6], P[B_+7]);                                             \
        auto r0 = __builtin_amdgcn_permlane32_swap(a0, b0, false, false); auto r1 = __builtin_amdgcn_permlane32_swap(a1, b1, false, false); \
        u32x4 w = {r0[0], r1[0], r0[1], r1[1]}; OUT = *reinterpret_cast<bf16x8*>(&w); } while (0)
    PK4(p0, 0, pa0); PK4(p0, 8, pa1); PK4(p1, 0, pa2); PK4(p1, 8, pa3);
#undef PK4
}
template <int KB, bool SK>
__device__ __forceinline__ void qkt(f32x16& p0, f32x16& p1, const char* K_lds, int r32, int hi, const bf16x8* qr, bool act, float bsl, int krel) {
    if (SK && !act) { const float NEG = -__builtin_inff();
#pragma unroll
        for (int r = 0; r < 16; ++r) { p0[r] = NEG; p1[r] = NEG; } return; }
    p0 = f32x16{}; p1 = f32x16{};
    const char* kb[4];
#pragma unroll
    for (int dd = 0; dd < 4; ++dd) kb[dd] = K_lds + KB * SHM_K + KSWZ(r32, (dd * 16 + hi * 8) * 2);
#pragma unroll
    for (int d0 = 0; d0 < 8; ++d0) { const char* a = kb[d0 & 3] + (d0 >> 2) * 128;
        bf16x8 b0 = *reinterpret_cast<const bf16x8*>(a);
        bf16x8 b1 = *reinterpret_cast<const bf16x8*>(a + 32 * 256);
        p0 = __builtin_amdgcn_mfma_f32_32x32x16_bf16(b0, qr[d0], p0, 0, 0, 0);
        p1 = __builtin_amdgcn_mfma_f32_32x32x16_bf16(b1, qr[d0], p1, 0, 0, 0); }
}
template <int VB, bool SK>
__device__ __forceinline__ void pv_tile(f32x16* o, int vb0, bf16x8 pa0, bf16x8 pa1, bf16x8 pa2, bf16x8 pa3, bool act) {
    if (SK && !act) return;
#define TRRD(dst, off) asm volatile("ds_read_b64_tr_b16 %0, %1 offset:%2" : "=&v"(dst) : "v"(vb0), "i"(off) : "memory")
#define PV_D0(d0) do { s16x4 l0, l1, l2, l3, h0, h1, h2, h3; constexpr int b_ = VB * SHM_V + v_rd_off(d0, 0, 0);     \
        TRRD(l0, b_); TRRD(h0, b_ + 2048); TRRD(l1, b_ + 4096); TRRD(h1, b_ + 6144); TRRD(l2, b_ + 8192); TRRD(h2, b_ + 10240); TRRD(l3, b_ + 12288); TRRD(h3, b_ + 14336); \
        asm volatile("s_waitcnt lgkmcnt(0)" ::: "memory"); SBAR();                 \
        o[d0] = __builtin_amdgcn_mfma_f32_32x32x16_bf16(pa0, (bf16x8){l0[0], l0[1], l0[2], l0[3], h0[0], h0[1], h0[2], h0[3]}, o[d0], 0, 0, 0);   \
        o[d0] = __builtin_amdgcn_mfma_f32_32x32x16_bf16(pa1, (bf16x8){l1[0], l1[1], l1[2], l1[3], h1[0], h1[1], h1[2], h1[3]}, o[d0], 0, 0, 0);   \
        o[d0] = __builtin_amdgcn_mfma_f32_32x32x16_bf16(pa2, (bf16x8){l2[0], l2[1], l2[2], l2[3], h2[0], h2[1], h2[2], h2[3]}, o[d0], 0, 0, 0);   \
        o[d0] = __builtin_amdgcn_mfma_f32_32x32x16_bf16(pa3, (bf16x8){l3[0], l3[1], l3[2], l3[3], h3[0], h3[1], h3[2], h3[3]}, o[d0], 0, 0, 0); } while (0)
    PV_D0(0); PV_D0(1); PV_D0(2); PV_D0(3);
#undef PV_D0
#undef TRRD
}

template <class TIn, class TOut> struct BlockRef { const TIn* Q; const TIn* K; const TIn* V; TOut* O; int P0; };
template <class TIn> struct Seam {
    bf16x8 qr[8];
    bf16x8 st_v0, st_v1, st_k0, st_k1; f32x4 sf0, sf1, sf2, sf3;
    f32x4 tq[16];
};
__device__ __forceinline__ int swa_jlo(int P0, int W) { const int lowk = P0 - W + 1; return lowk > 0 ? lowk / KVBLK : 0; }
#define ROW(p, k0, rr) ((p) + (size_t)((k0) + (rr)) * D + sc)
#define VMW() asm volatile("s_waitcnt vmcnt(0)" ::: "memory")
#define VMWN(n) asm volatile("s_waitcnt vmcnt(%0)" :: "i"(n) : "memory")
#define SLOAD_H(Kp, Vp, k0) do { S.st_v0 = load8<TIn>(ROW(Vp, k0, sr)); S.st_v1 = load8<TIn>(ROW(Vp, k0, 32 + sr));              \
                         S.st_k0 = load8<TIn>(ROW(Kp, k0, sr)); S.st_k1 = load8<TIn>(ROW(Kp, k0, 32 + sr)); } while (0)
#define SWRITE_HK(bf) do { *(bf16x8*)(K_lds + (bf) * SHM_K + kws) = S.st_k0; *(bf16x8*)(K_lds + (bf) * SHM_K + kws + 32 * 256) = S.st_k1; } while (0)
#define SWRITE_HV(bf) do { *(bf16x8*)(V_lds + (bf) * SHM_V + vst0) = S.st_v0; *(bf16x8*)(V_lds + (bf) * SHM_V + vst1) = S.st_v1; } while (0)
#define SWRITE_H(bf) do { SWRITE_HV(bf); SWRITE_HK(bf); } while (0)
#define SLOAD_F(p, k0) do { if constexpr (F32) { const float* p_ = (const float*)(p); S.sf0 = *(const f32x4*)ROW(p_, k0, sr); S.sf1 = *(const f32x4*)(ROW(p_, k0, sr) + 4);                \
                            S.sf2 = *(const f32x4*)ROW(p_, k0, 32 + sr); S.sf3 = *(const f32x4*)(ROW(p_, k0, 32 + sr) + 4); }                                       \
                            else { S.st_k0 = load8<TIn>(ROW(p, k0, sr)); S.st_k1 = load8<TIn>(ROW(p, k0, 32 + sr)); } } while (0)
#define SWRITE_KF(bf) do { if constexpr (F32) { *(bf16x8*)(K_lds + (bf) * SHM_K + kws) = pack8(S.sf0, S.sf1); *(bf16x8*)(K_lds + (bf) * SHM_K + kws + 32 * 256) = pack8(S.sf2, S.sf3); } \
                           else { *(bf16x8*)(K_lds + (bf) * SHM_K + kws) = S.st_k0; *(bf16x8*)(K_lds + (bf) * SHM_K + kws + 32 * 256) = S.st_k1; } } while (0)
#define SWRITE_VF(bf) do { if constexpr (F32) { *(bf16x8*)(V_lds + (bf) * SHM_V + vst0) = pack8(S.sf0, S.sf1); *(bf16x8*)(V_lds + (bf) * SHM_V + vst1) = pack8(S.sf2, S.sf3); } \
                           else { *(bf16x8*)(V_lds + (bf) * SHM_V + vst0) = S.st_k0; *(bf16x8*)(V_lds + (bf) * SHM_V + vst1) = S.st_k1; } } while (0)
template <class TIn, class TOut>
__device__ __forceinline__ void causal_swa_prime(const BlockRef<TIn, TOut>& cur, int W, char* lds, Seam<TIn>& S) {
    constexpr bool F32 = same_t<TIn, float>::v; constexpr bool SPL = F32 || SPLIT_KV;
    int tid_ = threadIdx.x; asm volatile("" : "+v"(tid_));
    const int tid = tid_, wid = __builtin_amdgcn_readfirstlane(tid >> 6), lane = tid & 63, r32 = lane & 31, hi = lane >> 5;
    const int sr = tid >> 4, sc = (tid & 15) * 8, kws = KSWZ(sr, sc * 2); char* K_lds = lds + 2 * SHM_V;
    const int kb0 = swa_jlo(cur.P0, W) * KVBLK;
    for (int d0 = 0; d0 < 8; ++d0) S.qr[d0] = load8<TIn>(cur.Q + (size_t)(wid * QBLK + r32) * D + d0 * 16 + hi * 8);
    if constexpr (SPL) { SLOAD_F(cur.K, kb0); VMW(); SWRITE_KF(0); SBAR(); SLOAD_F(cur.V, kb0); }
    else { SLOAD_H(cur.K, cur.V, kb0); VMW(); SWRITE_HK(0); }
    __syncthreads();
}
template <class TIn, class TOut>
__device__ __forceinline__ void causal_swa_block(const BlockRef<TIn, TOut>& cur, const BlockRef<TIn, TOut>& nxt, int skv, int W, char* lds, Seam<TIn>& S, float bsl) {
    constexpr bool F32 = same_t<TIn, float>::v; constexpr bool SPL = F32 || SPLIT_KV;
    int tid_ = threadIdx.x; asm volatile("" : "+v"(tid_));
    const int tid = tid_, wid = __builtin_amdgcn_readfirstlane(tid >> 6), lane = tid & 63, r32 = lane & 31, hi = lane >> 5;
    const int j_lo = swa_jlo(cur.P0, W);
    int j_hi = (cur.P0 + QB - 1) / KVBLK + 1; if (j_hi > skv / KVBLK) j_hi = skv / KVBLK;
    const int NT = j_hi - j_lo;
    const int kbn = swa_jlo(nxt.P0, W) * KVBLK;
    const int qlo = cur.P0 + wid * QBLK, qm = qlo + r32 - 4 * hi;
    char* V_lds = lds; char* K_lds = lds + 2 * SHM_V;
    float* ws = (float*)(lds + 2 * SHM_V + 2 * SHM_K) + wid * 64; float* li_l = ws, * al_l = ws + 32;
    float m_reg = -1e30f, l_reg = 0; f32x16 o[4] = {};
    const int sr = tid >> 4, sc = (tid & 15) * 8, vst0 = v_st(sr, sc), vst1 = v_st(32 + sr, sc), kws = KSWZ(sr, sc * 2);
    const int vb0 = (int)(uintptr_t)V_lds + v_rd_base(lane);
    const TIn* Kh = cur.K; const TIn* Vh = cur.V;
#define RESC(a) do { if (__any((a) < 1.f)) { if (hi == 0) al_l[r32] = (a); asm volatile("s_waitcnt lgkmcnt(0)" ::: "memory");              \
                     for (int d_ = 0; d_ < 4; ++d_) for (int r = 0; r < 16; ++r) o[d_][r] *= al_l[crow(r, hi)]; } } while (0)
#define KBASE(t) ((j_lo + (t)) * KVBLK)
#define ACT(t) (KBASE(t) <= qlo + QBLK - 1 && KBASE(t) + KVBLK - 1 >= qlo - W + 1)
#define MASKT(P0_, P1_, t) do { alibi_add(P0_, P1_, bsl, KBASE(t) - cur.P0, hi); const int kb_ = KBASE(t); if ((!SK || ACT(t)) && (kb_ + KVBLK - 1 > qlo || kb_ <= qlo + QBLK - 1 - W)) mask_tile(P0_, P1_, qm - kb_, (unsigned)W); } while (0)
    constexpr int NQL = F32 ? 16 : 8;
    constexpr bool SK = WSKIP && !F32;
#define SEAM_K0() do { VMWN(NQL); if constexpr (SPL) { SWRITE_KF(0); SBAR(); SLOAD_F(nxt.V, kbn); } else { SWRITE_HK(0); } SBAR(); } while (0)
    f32x16 pA0, pA1, pB0, pB1; float mnA, mnB, alA, alB; bf16x8 pa0, pa1, pa2, pa3;
    if constexpr (SPL) { VMW(); SWRITE_VF(0); SBAR(); } else { SWRITE_HV(0); SBAR(); }
    if (NT > 1) { if constexpr (SPL) SLOAD_F(Kh, KBASE(1)); else SLOAD_H(Kh, Vh, KBASE(1)); }
    SBAR(); qkt<0, SK>(pA0, pA1, K_lds, r32, hi, S.qr, ACT(0), bsl, KBASE(0) - cur.P0);
    if constexpr (SPL) { if (NT > 1) { VMW(); SWRITE_KF(1); SBAR(); SLOAD_F(Vh, KBASE(1)); } }
    MASKT(pA0, pA1, 0); partialSM(pA0, pA1, m_reg, mnA, alA);
    if (NT > 1) { VMW(); if constexpr (SPL) { SWRITE_VF(1); SBAR(); if (NT > 2) SLOAD_F(Kh, KBASE(2)); } else SWRITE_H(1); }
    __syncthreads();
#define HALF_STEP(PX0, PX1, mnX, alX, PY0, PY1, alY, t, KB, VB, SB) do {                                                      \
        SBAR(); qkt<KB, SK>(PX0, PX1, K_lds, r32, hi, S.qr, ACT(t), bsl, KBASE(t) - cur.P0);                                             \
        finishSM(PY0, PY1, alY, l_reg, pa0, pa1, pa2, pa3); SBAR();                                                           \
        if ((t) + 1 < NT) { if constexpr (SPL) { VMW(); SWRITE_KF(SB); SBAR(); SLOAD_F(Vh, KBASE((t) + 1)); }  \
                            else { SLOAD_H(Kh, Vh, KBASE((t) + 1)); } SBAR(); }                                               \
        pv_tile<VB, SK>(o, vb0, pa0, pa1, pa2, pa3, ACT((t) - 1)); MASKT(PX0, PX1, (t)); partialSM(PX0, PX1, m_reg, mnX, alX);                                        \
        __syncthreads();                                                                                                      \
        if ((t) + 1 < NT) { VMW(); if constexpr (SPL) { SWRITE_VF(SB); SBAR(); if ((t) + 2 < NT) SLOAD_F(Kh, KBASE((t) + 2)); } \
                            else { SWRITE_H(SB); } }                                                                          \
        RESC(alX); __syncthreads(); } while (0)
    for (int t = 1; t + 1 < NT; t += 2) {
        HALF_STEP(pB0, pB1, mnB, alB, pA0, pA1, alA, t, 1, 0, 0);
        HALF_STEP(pA0, pA1, mnA, alA, pB0, pB1, alB, t + 1, 0, 1, 1);
    }
    const bool even = (NT & 1) == 0;
    if (even) { SBAR(); qkt<1, SK>(pB0, pB1, K_lds, r32, hi, S.qr, ACT(NT - 1), bsl, KBASE(NT - 1) - cur.P0); SBAR(); }
#define QROW(e) (nxt.Q + (size_t)(wid * QBLK + r32) * D + ((e) >> 1) * 16 + hi * 8 + ((e) & 1) * 4)
    if constexpr (F32) { SLOAD_F(nxt.K, kbn); SBAR();
#pragma unroll
        for (int e = 0; e < 8; ++e) S.tq[e] = *(const f32x4*)QROW(e); }
    else { if constexpr (SPL) SLOAD_F(nxt.K, kbn); else SLOAD_H(nxt.K, nxt.V, kbn); SBAR();
#pragma unroll
        for (int d0 = 0; d0 < 8; ++d0) S.qr[d0] = load8<TIn>(nxt.Q + (size_t)(wid * QBLK + r32) * D + d0 * 16 + hi * 8); }
    SBAR();
    finishSM(pA0, pA1, alA, l_reg, pa0, pa1, pa2, pa3); SBAR();
    if constexpr (F32) {
#pragma unroll
        for (int e = 8; e < 16; ++e) S.tq[e] = *(const f32x4*)QROW(e); SBAR(); }
#undef QROW
    pv_tile<0, SK>(o, vb0, pa0, pa1, pa2, pa3, ACT(even ? NT - 2 : NT - 1));
    if (even) { MASKT(pB0, pB1, NT - 1); partialSM(pB0, pB1, m_reg, mnB, alB); __syncthreads(); RESC(alB);
        finishSM(pB0, pB1, alB, l_reg, pa0, pa1, pa2, pa3); SBAR(); pv_tile<1, SK>(o, vb0, pa0, pa1, pa2, pa3, ACT(NT - 1)); }
    SBAR(); SEAM_K0();
    if (hi == 0) li_l[r32] = l_reg; asm volatile("s_waitcnt lgkmcnt(0)" ::: "memory");
    float rli[16];
#pragma unroll
    for (int r = 0; r < 16; ++r) rli[r] = __builtin_amdgcn_rcpf(li_l[crow(r, hi)]);
    TOut* Ow = cur.O + (size_t)(wid * QBLK) * D;
#pragma unroll
    for (int r = 0; r < 16; ++r) { const int orow = crow(r, hi);
#pragma unroll
        for (int d0 = 0; d0 < 4; ++d0) { const float v = o[d0][r] * rli[r];
            if constexpr (same_t<TOut, float>::v) { Ow[(size_t)orow * D + d0 * 32 + r32] = v; }
            else { const float vn = __shfl_xor(v, 1);
                   if ((r32 & 1) == 0) *(unsigned*)(Ow + (size_t)orow * D + d0 * 32 + r32) = cvtpk(v, vn); } } }
    if constexpr (F32) {
#pragma unroll
        for (int d0 = 0; d0 < 8; ++d0) S.qr[d0] = pack8(S.tq[2 * d0], S.tq[2 * d0 + 1]); }
    __syncthreads();
#undef RESC
#undef KBASE
#undef ACT
#undef MASKT
#undef SEAM_K0
#undef HALF_STEP
}
#undef ROW
#undef VMW
#undef VMWN
#undef SLOAD_H
#undef SWRITE_HK
#undef SWRITE_HV
#undef SWRITE_H
#undef SLOAD_F
#undef SWRITE_KF
#undef SWRITE_VF
}

#define XB_TMO      128
#define XB_XCNT(j)  (256  + 64 * (j))
#define XB_XSUB(j)  (1280 + 64 * (j))
#define XB_XGEN(j)  (2304 + 64 * (j))
#define XB_TOP      3328
#define XB_TOPGEN   3392
#define XCD_BAR_WORDS 3456
#define XB_SPIN_CAP (1u << 18)

__device__ __forceinline__ unsigned xb_ld(unsigned* p)              { return __hip_atomic_load(p, __ATOMIC_RELAXED, __HIP_MEMORY_SCOPE_AGENT); }
__device__ __forceinline__ unsigned xb_add(unsigned* p, unsigned v) { return __hip_atomic_fetch_add(p, v, __ATOMIC_RELAXED, __HIP_MEMORY_SCOPE_AGENT); }
__device__ __forceinline__ unsigned xb_xcc_id() { return (unsigned)__builtin_amdgcn_s_getreg((3 << 11) | 20) & 0xFu; }
#define XB_SPIN(cond, bar) do { unsigned _sp = 0; while (cond) { __builtin_amdgcn_s_sleep(1); \
    if ((++_sp & 255u) == 0u) { if (xb_ld(&(bar)[XB_TMO])) break; if (_sp > XB_SPIN_CAP) { atomicAdd(&(bar)[XB_TMO], 1u); break; } } } } while (0)

struct XcdBarrier {
    unsigned* bar; unsigned x;
    volatile LAS unsigned* st;
};

__device__ __forceinline__ XcdBarrier xcd_barrier_post(unsigned* bar, volatile LAS unsigned* st) {
    XcdBarrier b; b.bar = bar; b.x = xb_xcc_id(); b.st = st;
    if (threadIdx.x == 0) (void)xb_add(&bar[XB_XCNT(b.x)], 1u);
    return b;
}
__device__ __forceinline__ void xcd_barrier_complete(unsigned* bar, unsigned x, unsigned& nloc, unsigned& nx) {
    const unsigned G = gridDim.x * gridDim.y * gridDim.z;
    unsigned sum, cnt, mine, sp = 0u;
    for (;;) {
        sum = 0u; cnt = 0u; mine = 0u;
#pragma unroll
        for (unsigned j = 0; j < 16; ++j) { const unsigned c = xb_ld(&bar[XB_XCNT(j)]); sum += c; cnt += (c > 0u) ? 1u : 0u; mine = (j == x) ? c : mine; }
        if (sum == G) break;
        __builtin_amdgcn_s_sleep(1);
        if ((++sp & 255u) == 0u) { if (xb_ld(&bar[XB_TMO])) break; if (sp > XB_SPIN_CAP) { atomicAdd(&bar[XB_TMO], 1u); break; } }
    }
    nloc = mine > 0u ? mine : 1u; nx = cnt > 0u ? cnt : 1u;
}

__device__ __forceinline__ void xcd_barrier(const XcdBarrier& b) {
    asm volatile("s_waitcnt vmcnt(0)" ::: "memory");
    __syncthreads();
    if (threadIdx.x == 0) {
        unsigned* bar = b.bar;
        __builtin_amdgcn_s_waitcnt(0);
        unsigned nloc = b.st[0], nx = b.st[1];
        if (nloc == 0u) { xcd_barrier_complete(bar, b.x, nloc, nx); b.st[0] = nloc; b.st[1] = nx; }
        const unsigned old = xb_add(&bar[XB_XSUB(b.x)], 1u);
        const unsigned gen = old / nloc;
        if (old + 1u == (gen + 1u) * nloc) {
            __builtin_amdgcn_fence(__ATOMIC_RELEASE, "agent");
            asm volatile("s_waitcnt vmcnt(0)" ::: "memory");
            const unsigned og = xb_add(&bar[XB_TOP], 1u);
            const unsigned tg = og / nx;
            if (og + 1u == (tg + 1u) * nx) xb_add(&bar[XB_TOPGEN], 1u);
            else XB_SPIN(xb_ld(&bar[XB_TOPGEN]) == tg, bar);
            __builtin_amdgcn_fence(__ATOMIC_ACQUIRE, "agent");
            xb_add(&bar[XB_XGEN(b.x)], 1u);
            asm volatile("s_waitcnt vmcnt(0)" ::: "memory");
        } else {
            XB_SPIN(xb_ld(&bar[XB_XGEN(b.x)]) == gen, bar);
            __builtin_amdgcn_fence(__ATOMIC_ACQUIRE, "agent");
            asm volatile("s_waitcnt vmcnt(0)" ::: "memory");
        }
    }
    __syncthreads();
}


namespace ret {
constexpr int C = 64, QP = 528  , VP = 144  ;
constexpr int OFF_Q = 0, OFF_K = OFF_Q + 64 * QP, OFF_ST = OFF_K + 64 * QP, OFF_V = OFF_ST + 64 * QP, OFF_V2 = OFF_V + 64 * VP, OFF_P = OFF_V2 + 64 * VP, LDS_END = OFF_P + 64 * VP;
static_assert(LDS_END <= 131072, "retention LDS");
__device__ __forceinline__ int crow(int r, int hi) { return (r & 3) + 8 * (r >> 2) + 4 * hi; }
#define RET_TR(dst, addr) asm volatile("ds_read_b64_tr_b16 %0, %1" : "=&v"(dst) : "v"(addr) : "memory")
#define RET_MK8(lo, hi4) ((bf16x8){lo[0], lo[1], lo[2], lo[3], hi4[0], hi4[1], hi4[2], hi4[3]})

__device__ __forceinline__ void unit(LAS unsigned char* lds, const bf16* __restrict__ Q, const bf16* __restrict__ K, const bf16* __restrict__ V, bf16* __restrict__ O, float lg) {
    int tid_ = threadIdx.x; asm volatile("" : "+v"(tid_));
    const int tid = tid_, wid = __builtin_amdgcn_readfirstlane(tid >> 6), lane = tid & 63, r = lane & 31, hi = lane >> 5;
    const unsigned lb = (unsigned)(size_t)lds;
    const int tq = (lane & 15) >> 2, tp = lane & 3, tblk = (lane >> 4) & 1;
    { unsigned z_ = 0u; asm volatile("" : "+v"(z_));
      for (int i = tid; i < 64 * QP / 16; i += 512) *(LAS v4u*)(lds + OFF_ST + i * 16) = (v4u){z_, z_, z_, z_}; }
    f32x16 st0 = {}, st1 = {};
    const float chd = __builtin_amdgcn_exp2f(lg * 64.f);
    float fac[16];
    const int t_a = (wid & 3) >> 1, t_b = wid & 1;
#pragma unroll
    for (int g = 0; g < 16; ++g) {
        if (wid < 4) { const int dlt = (32 * t_b + r) - (32 * t_a + crow(g, hi)); fac[g] = dlt >= 0 ? __builtin_amdgcn_exp2f(lg * (float)dlt) : 0.f; }
        else { fac[g] = __builtin_amdgcn_exp2f(lg * (float)(32 * t_a + crow(g, hi) + 1)); }
    }
    const int vrow = tid >> 3, vch = tid & 7;
    const float vsc = __builtin_amdgcn_exp2f(lg * (float)(63 - vrow));
    v4u pq[4], pk[4], pv;
#pragma unroll
    for (int i = 0; i < 4; ++i) { const int p = tid + 512 * i; pq[i] = *(const v4u*)(Q + (size_t)(p >> 5) * 256 + (p & 31) * 8); pk[i] = *(const v4u*)(K + (size_t)(p >> 5) * 256 + (p & 31) * 8); }
    pv = *(const v4u*)(V + (size_t)vrow * 64 + vch * 8);
    for (int c = 0; c < SEQ / C; ++c) {
#pragma unroll
        for (int i = 0; i < 4; ++i) { const int p = tid + 512 * i; *(LAS v4u*)(lds + OFF_Q + (p >> 5) * QP + (p & 31) * 16) = pq[i]; *(LAS v4u*)(lds + OFF_K + (p >> 5) * QP + (p & 31) * 16) = pk[i]; }
        *(LAS v4u*)(lds + OFF_V + vrow * VP + vch * 16) = pv;
        { v4u w; w.x = cvtpk(bflo(pv.x) * vsc, bfhi(pv.x) * vsc); w.y = cvtpk(bflo(pv.y) * vsc, bfhi(pv.y) * vsc); w.z = cvtpk(bflo(pv.z) * vsc, bfhi(pv.z) * vsc); w.w = cvtpk(bflo(pv.w) * vsc, bfhi(pv.w) * vsc);
          *(LAS v4u*)(lds + OFF_V2 + vrow * VP + vch * 16) = w; }
        __syncthreads();
        if (c + 1 < SEQ / C) {
            const size_t ro = (size_t)(c + 1) * C;
#pragma unroll
            for (int i = 0; i < 4; ++i) { const int p = tid + 512 * i; pq[i] = *(const v4u*)(Q + (ro + (p >> 5)) * 256 + (p & 31) * 8); pk[i] = *(const v4u*)(K + (ro + (p >> 5)) * 256 + (p & 31) * 8); }
            pv = *(const v4u*)(V + (ro + vrow) * 64 + vch * 8);
        }
        f32x16 acc = {};
        if (wid < 4) {
            const int jb = t_a, ib = t_b;
            if (!(jb == 1 && ib == 0)) {
                const LAS unsigned char* ka = lds + OFF_K + (32 * jb + r) * QP + hi * 16; const LAS unsigned char* qa = lds + OFF_Q + (32 * ib + r) * QP + hi * 16;
#pragma unroll
                for (int ks = 0; ks < 16; ++ks) acc = __builtin_amdgcn_mfma_f32_32x32x16_bf16(*(const LAS bf16x8*)(ka + ks * 32), *(const LAS bf16x8*)(qa + ks * 32), acc, 0, 0, 0);
            }
            LAS unsigned char* pw = lds + OFF_P + (32 * ib + r) * VP + (32 * jb + 4 * hi) * 2;
#pragma unroll
            for (int g = 0; g < 4; ++g) { v2u w; w.x = cvtpk(acc[4 * g] * fac[4 * g], acc[4 * g + 1] * fac[4 * g + 1]); w.y = cvtpk(acc[4 * g + 2] * fac[4 * g + 2], acc[4 * g + 3] * fac[4 * g + 3]); *(LAS v2u*)(pw + g * 16) = w; }
        } else {
            const int ib = t_a, eb = t_b;
            const LAS unsigned char* qa = lds + OFF_Q + (32 * ib + r) * QP + hi * 16; const LAS unsigned char* sa = lds + OFF_ST + (32 * eb + r) * QP + hi * 16;
#pragma unroll
            for (int ks = 0; ks < 16; ++ks) acc = __builtin_amdgcn_mfma_f32_32x32x16_bf16(*(const LAS bf16x8*)(qa + ks * 32), *(const LAS bf16x8*)(sa + ks * 32), acc, 0, 0, 0);
#pragma unroll
            for (int g = 0; g < 16; ++g) acc[g] *= fac[g];
        }
        __syncthreads();
        const unsigned va = lb + OFF_V + (8 * hi + tq) * VP + (16 * tblk + 4 * tp) * 2, v2a = va + (OFF_V2 - OFF_V);
        if (wid >= 4) {
            const int ib = t_a, eb = t_b;
            const LAS unsigned char* pa = lds + OFF_P + (32 * ib + r) * VP + hi * 16;
            s16x4 l0, h0, l1, h1, l2, h2, l3, h3;
            RET_TR(l0, va + eb * 64 + 0 * 16 * VP); RET_TR(h0, va + eb * 64 + 0 * 16 * VP + 4 * VP); RET_TR(l1, va + eb * 64 + 1 * 16 * VP); RET_TR(h1, va + eb * 64 + 1 * 16 * VP + 4 * VP);
            RET_TR(l2, va + eb * 64 + 2 * 16 * VP); RET_TR(h2, va + eb * 64 + 2 * 16 * VP + 4 * VP); RET_TR(l3, va + eb * 64 + 3 * 16 * VP); RET_TR(h3, va + eb * 64 + 3 * 16 * VP + 4 * VP);
            const bf16x8 a0 = *(const LAS bf16x8*)(pa), a1 = *(const LAS bf16x8*)(pa + 32), a2 = *(const LAS bf16x8*)(pa + 64), a3 = *(const LAS bf16x8*)(pa + 96);
            asm volatile("s_waitcnt lgkmcnt(0)" ::: "memory"); __builtin_amdgcn_sched_barrier(0);
            acc = __builtin_amdgcn_mfma_f32_32x32x16_bf16(a0, RET_MK8(l0, h0), acc, 0, 0, 0);
            acc = __builtin_amdgcn_mfma_f32_32x32x16_bf16(a1, RET_MK8(l1, h1), acc, 0, 0, 0);
            acc = __builtin_amdgcn_mfma_f32_32x32x16_bf16(a2, RET_MK8(l2, h2), acc, 0, 0, 0);
            acc = __builtin_amdgcn_mfma_f32_32x32x16_bf16(a3, RET_MK8(l3, h3), acc, 0, 0, 0);
            bf16* op = O + ((size_t)c * C + 32 * ib) * 2048 + 32 * eb + r;
#pragma unroll
            for (int g = 0; g < 16; ++g) { const float v = acc[g]; const float vn = __shfl_xor(v, 1); if ((r & 1) == 0) *(unsigned*)(op + (size_t)crow(g, hi) * 2048) = cvtpk(v, vn); }
        }
        {
            const unsigned ka = lb + OFF_K + (8 * hi + tq) * QP + (32 * wid + 16 * tblk + 4 * tp) * 2;
            s16x4 kl[4], kh[4], xl[4], xh[4], yl[4], yh[4];
#pragma unroll
            for (int ks = 0; ks < 4; ++ks) { RET_TR(kl[ks], ka + ks * 16 * QP); RET_TR(kh[ks], ka + ks * 16 * QP + 4 * QP);
                RET_TR(xl[ks], v2a + ks * 16 * VP); RET_TR(xh[ks], v2a + ks * 16 * VP + 4 * VP); RET_TR(yl[ks], v2a + 64 + ks * 16 * VP); RET_TR(yh[ks], v2a + 64 + ks * 16 * VP + 4 * VP); }
#pragma unroll
            for (int g = 0; g < 16; ++g) { st0[g] *= chd; st1[g] *= chd; }
            asm volatile("s_waitcnt lgkmcnt(0)" ::: "memory"); __builtin_amdgcn_sched_barrier(0);
#pragma unroll
            for (int ks = 0; ks < 4; ++ks) { const bf16x8 a = RET_MK8(kl[ks], kh[ks]);
                st0 = __builtin_amdgcn_mfma_f32_32x32x16_bf16(a, RET_MK8(xl[ks], xh[ks]), st0, 0, 0, 0);
                st1 = __builtin_amdgcn_mfma_f32_32x32x16_bf16(a, RET_MK8(yl[ks], yh[ks]), st1, 0, 0, 0); }
            LAS unsigned char* sw = lds + OFF_ST + r * QP + (32 * wid + 4 * hi) * 2;
#pragma unroll
            for (int g = 0; g < 4; ++g) { v2u w0, w1; w0.x = cvtpk(st0[4 * g], st0[4 * g + 1]); w0.y = cvtpk(st0[4 * g + 2], st0[4 * g + 3]); w1.x = cvtpk(st1[4 * g], st1[4 * g + 1]); w1.y = cvtpk(st1[4 * g + 2], st1[4 * g + 3]);
                *(LAS v2u*)(sw + g * 16) = w0; *(LAS v2u*)(sw + 32 * QP + g * 16) = w1; }
        }
        __syncthreads();
    }
}
#undef RET_TR
#undef RET_MK8
}

__device__ __forceinline__ void rms_row_bf16(const float* xrow, const float* g, bf16* orow, int lane) {
    const f32x4* xr = (const f32x4*)xrow + lane; const f32x4* gr = (const f32x4*)g + lane;
    f32x4 v[4]; float s = 0.f;
#pragma unroll
    for (int j = 0; j < 4; ++j) { v[j] = xr[64 * j]; s += (v[j].x * v[j].x + v[j].y * v[j].y) + (v[j].z * v[j].z + v[j].w * v[j].w); }
    const float rstd = 1.0f / sqrtf(wave_sum(s) * (1.f / 1024.f) + EPS);
    v2u* o8 = (v2u*)orow + lane;
#pragma unroll
    for (int j = 0; j < 4; ++j) { const f32x4 gg = gr[64 * j]; v2u w; w.x = cvtpk(v[j].x * rstd * gg.x, v[j].y * rstd * gg.y); w.y = cvtpk(v[j].z * rstd * gg.z, v[j].w * rstd * gg.w); o8[64 * j] = w; }
}
__device__ __forceinline__ void rms_row_f32(float* xrow, const float* g, int lane) {
    f32x4* xr = (f32x4*)xrow + lane; const f32x4* gr = (const f32x4*)g + lane;
    f32x4 v[4]; float s = 0.f;
#pragma unroll
    for (int j = 0; j < 4; ++j) { v[j] = xr[64 * j]; s += (v[j].x * v[j].x + v[j].y * v[j].y) + (v[j].z * v[j].z + v[j].w * v[j].w); }
    const float rstd = 1.0f / sqrtf(wave_sum(s) * (1.f / 1024.f) + EPS);
#pragma unroll
    for (int j = 0; j < 4; ++j) { const f32x4 gg = gr[64 * j]; xr[64 * j] = (f32x4){v[j].x * rstd * gg.x, v[j].y * rstd * gg.y, v[j].z * rstd * gg.z, v[j].w * rstd * gg.w}; }
}
__device__ __forceinline__ void ret_norm_row(const bf16* raw, bf16* srg, const float* g, int lane) {
    const v4u rv = *((const v4u*)raw + lane); const v4u sv = *((const v4u*)srg + lane);
    float x[8] = {bflo(rv.x), bfhi(rv.x), bflo(rv.y), bfhi(rv.y), bflo(rv.z), bfhi(rv.z), bflo(rv.w), bfhi(rv.w)};
    const float sg[8] = {bflo(sv.x), bfhi(sv.x), bflo(sv.y), bfhi(sv.y), bflo(sv.z), bfhi(sv.z), bflo(sv.w), bfhi(sv.w)};
    float s = 0.f;
#pragma unroll
    for (int j = 0; j < 8; ++j) s += x[j];
    const float mean = wave_sum(s) * (1.f / 512.f); float q = 0.f;
#pragma unroll
    for (int j = 0; j < 8; ++j) { x[j] -= mean; q += x[j] * x[j]; }
    const float rstd = 1.0f / sqrtf(wave_sum(q) * (1.f / 512.f) + EPS);
    const f32x4 g0 = *((const f32x4*)g + 2 * lane), g1 = *((const f32x4*)g + 2 * lane + 1);
    v4u w; w.x = cvtpk(x[0] * rstd * g0.x * sg[0], x[1] * rstd * g0.y * sg[1]); w.y = cvtpk(x[2] * rstd * g0.z * sg[2], x[3] * rstd * g0.w * sg[3]);
    w.z = cvtpk(x[4] * rstd * g1.x * sg[4], x[5] * rstd * g1.y * sg[5]); w.w = cvtpk(x[6] * rstd * g1.z * sg[6], x[7] * rstd * g1.w * sg[7]);
    *((v4u*)srg + lane) = w;
}
__device__ __forceinline__ void diff_norm_row(const bf16* o1, const bf16* o2, size_t hs, bf16* out, const float* g, float lam, float osc, int lane) {
    const int half = lane >> 5, c = (lane & 31) * 4;
    const v2u a = *(const v2u*)(o1 + half * hs + c), b = *(const v2u*)(o2 + half * hs + c);
    float d[4] = {bflo(a.x) - lam * bflo(b.x), bfhi(a.x) - lam * bfhi(b.x), bflo(a.y) - lam * bflo(b.y), bfhi(a.y) - lam * bfhi(b.y)};
    const float q = (d[0] * d[0] + d[1] * d[1]) + (d[2] * d[2] + d[3] * d[3]);
    const float rstd = osc / sqrtf(wave_sum(q) * (1.f / 256.f) + EPS);
    const f32x4 gg = *(const f32x4*)(g + half * 128 + c);
    v2u w; w.x = cvtpk(d[0] * rstd * gg.x, d[1] * rstd * gg.y); w.y = cvtpk(d[2] * rstd * gg.z, d[3] * rstd * gg.w);
    *(v2u*)(out + half * 128 + c) = w;
}
__device__ __forceinline__ void transpose_item(const float* W, int ldw, int K, int nblk, bf16* WT, int zperm, LAS float* scr, int item, int lane) {
    const int kb = item / nblk, nb = item % nblk, k0 = 64 * kb, n0 = 32 * nb;
#pragma unroll 8
    for (int i = 0; i < 32; ++i) { const int kk = 2 * i + (lane >> 5); scr[kk * 33 + (lane & 31)] = W[(size_t)(k0 + kk) * ldw + n0 + (lane & 31)]; }
    LDS_WAIT(); asm volatile("" ::: "memory");
    int d0 = n0;
    if (zperm) d0 = n0 < 4096 ? n0 : (n0 < 6144 ? n0 + 3072 : (n0 < 9216 ? n0 - 2048 : n0));
    const int c = lane & 7;
#pragma unroll
    for (int j = 0; j < 4; ++j) { const int n = (lane >> 3) + 8 * j; const LAS float* s = scr + (8 * c) * 33 + n;
        v4u o; o.x = cvtpk(s[0 * 33], s[1 * 33]); o.y = cvtpk(s[2 * 33], s[3 * 33]); o.z = cvtpk(s[4 * 33], s[5 * 33]); o.w = cvtpk(s[6 * 33], s[7 * 33]);
        *(v4u*)(WT + (size_t)(d0 + n) * K + k0 + 8 * c) = o; }
    LDS_WAIT(); asm volatile("" ::: "memory");
}

__device__ __forceinline__ da::BlockRef<bf16, bf16> da_ref(int L, int pass, const bf16* DQ, const bf16* DK, const bf16* DV, bf16* ODIFF) {
    constexpr int NQB = SEQ / 256, NX = NQB / 2;
    const int a = L / NX, xx = L % NX, qb = pass ? (NQB - 1 - xx) : xx; const int bh = a >> 2, mp = (a >> 1) & 1, hf = a & 1;
    da::BlockRef<bf16, bf16> rr; rr.Q = DQ + ((size_t)(bh * 2 + mp) * SEQ + (size_t)qb * 256) * 128; rr.K = DK + (size_t)(bh * 2 + mp) * SEQ * 128; rr.V = DV + (size_t)(bh * 2 + hf) * SEQ * 128;
    rr.O = ODIFF + ((size_t)a * SEQ + (size_t)qb * 256) * 128; rr.P0 = qb * 256; return rr;
}

constexpr size_t MiB = 1u << 20;
constexpr size_t WS_CTL = 0, CTL_ZERO_BYTES = 1 * MiB;
constexpr size_t WS_W = 1 * MiB;
constexpr size_t W_IN = 0, W_RETO = W_IN + (size_t)DIN * DM, W_DIFFO = W_RETO + 2048 * 1024, W_KV = W_DIFFO + 1024 * 1024, W_CROSSO = W_KV + 2048 * 1024,
                 W_OUT = W_CROSSO + 1024 * 1024, W_UP = W_OUT + 1024 * 1024, W_DOWN = W_UP + 4096 * 1024, W_END = W_DOWN + 4096 * 1024;
static_assert(W_END * 2 == 56 * MiB, "weight map");
constexpr size_t WS_MEMN = 57 * MiB, WS_MK = 61 * MiB, WS_MVT = 65 * MiB;
constexpr size_t WS_H = 69 * MiB;
constexpr size_t WS_Z = 101 * MiB;
constexpr size_t WS_RQ = WS_Z, WS_RK = WS_RQ + 32 * MiB, WS_RV = WS_RK + 32 * MiB, WS_DQ = WS_RV + 64 * MiB, WS_DK = WS_DQ + 32 * MiB, WS_DV = WS_DK + 32 * MiB;
constexpr size_t WS_RETRAW = 325 * MiB, WS_ODIFF = 389 * MiB, WS_END = 453 * MiB;
constexpr size_t WS_SRG = WS_Z, WS_CQ = WS_SRG + 64 * MiB, WS_GATES = WS_CQ + 32 * MiB, WS_P = WS_GATES + 96 * MiB;
static_assert(WS_P + 32 * MiB <= WS_RETRAW, "overlay map");
constexpr size_t WS_DA = WS_H, WS_CA = WS_RETRAW, WS_MF = WS_ODIFF, WS_MB = WS_CQ;
constexpr size_t WS_H2 = 69 * MiB, WS_U = 133 * MiB;
static_assert(WS_U + 256 * MiB <= WS_END, "ffn map");

constexpr int CW_TMO = 0;
constexpr int CW_BAR = 4096;
constexpr int RING_OFF = 0, RING_BYTES = 131072;
constexpr int LDSCTL_OFF = RING_BYTES, MISC_OFF = LDSCTL_OFF + 320;
constexpr int LDS_BYTES = 147456;
static_assert(MISC_OFF + 128 <= LDS_BYTES, "LDS map");

constexpr int PH_PER_LAYER = 19, NPHASE = DEPTH * PH_PER_LAYER + 1;
#ifndef ENMASK
#define ENMASK 0xffffffffu
#endif
#define EN(k) (((ENMASK) >> (k)) & 1u)
struct Args { const float* in[20]; float* out; unsigned char* ws; int ph_lo, ph_hi; };

__global__ void __launch_bounds__(NWAVES * 64, 2) fwd_kernel(Args args) {
    extern __shared__ __attribute__((aligned(16))) unsigned char lds_raw[];
    LAS unsigned char* lds = (LAS unsigned char*)lds_raw;
    volatile LAS unsigned* MISC = (volatile LAS unsigned*)(lds + MISC_OFF);
    const int tid = threadIdx.x;
    unsigned char* ws = args.ws;
    gu32* ctl = (gu32*)(ws + WS_CTL);
    for (int u = tid; u < (LDS_BYTES - LDSCTL_OFF) / 4; u += NWAVES * 64) ((LAS unsigned*)(lds + LDSCTL_OFF))[u] = 0u;
    __syncthreads();
    if (!MK_PER_PHASE) (void)xcd_barrier_post((unsigned*)(ctl + CW_BAR), MISC + 8);
    const int lo = args.ph_lo, hi = args.ph_hi;
    int ph = 0;
#define PH_ON (ph >= lo && ph < hi)
#define PH_END do { if (PH_ON && ph + 1 < hi) { GAS unsigned* bp_ = (GAS unsigned*)args.ws + CW_BAR; asm volatile("" : "+s"(bp_)); XcdBarrier b_; b_.bar = (unsigned*)bp_; b_.x = xb_xcc_id(); b_.st = MISC + 8; xcd_barrier(b_); } ++ph; } while (0)

#define CAS __attribute__((address_space(4)))
#define PH_LOCALS0 GAS unsigned char* wsl = (GAS unsigned char*)args.ws; asm volatile("" : "+s"(wsl)); const CAS char* kal = (const CAS char*)__builtin_amdgcn_kernarg_segment_ptr(); asm volatile("" : "+s"(kal)); \
    float* out = (float*)(GAS float*)(*(float* const CAS*)(kal + 160)); int ltid_ = threadIdx.x; asm volatile("" : "+v"(ltid_)); int bx_ = blockIdx.x, G_ = gridDim.x; asm volatile("" : "+s"(bx_), "+s"(G_)); const int bx = bx_, G = G_; const int lane = ltid_ & 63, wave = __builtin_amdgcn_readfirstlane(ltid_ >> 6); \
    const int vcu = (G % 8 == 0) ? (bx % 8) * (G / 8) + bx / 8 : bx, gw = vcu * NWAVES + wave, NGW = G * NWAVES; (void)lane; (void)gw; (void)NGW;
#define PH_LOCALS_L PH_LOCALS0; int l = layer; asm volatile("" : "+s"(l));
#define PH_LOCALS PH_LOCALS_L; int grp = group; asm volatile("" : "+s"(grp)); const size_t row0 = (size_t)grp * MG; (void)row0;
#define AIN(i) ((const float*)(const GAS float*)(*(const float* const CAS*)(kal + 8 * (i))))
#define WSB(off) ((bf16*)(GAS bf16*)(wsl + (off)))
#define Wt WSB(WS_W)
    for (int layer = 0; layer < DEPTH; ++layer) {
        if (PH_ON && EN(0)) { PH_LOCALS_L; const float* xsrc = (l == 0) ? AIN(0) : out; const float* mem = AIN(1); bf16 *MEMN = WSB(WS_MEMN), *H = WSB(WS_H);
            LAS float* scr = (LAS float*)(lds + RING_OFF + wave * 16384);
            const float* w_in = AIN(3) + (size_t)l * DM * DIN; const float* w_reto = AIN(5) + (size_t)l * 2048 * 1024; const float* w_diffo = AIN(11) + (size_t)l * 1024 * 1024;
            const float* w_kv = AIN(13) + (size_t)l * 1024 * 2048; const float* w_crosso = AIN(14) + (size_t)l * 1024 * 1024; const float* w_out = AIN(15) + (size_t)l * 1024 * 1024;
            const float* w_up = AIN(17) + (size_t)l * 1024 * 4096; const float* w_down = AIN(18) + (size_t)l * 4096 * 1024;
            constexpr int I_IN = 16 * 416, I_RETO = 32 * 32, I_SQ = 16 * 32, I_KV = 16 * 64, I_UP = 16 * 128, I_DOWN = 64 * 32;
            constexpr int NITEMS = I_IN + I_RETO + I_SQ + I_KV + I_SQ + I_SQ + I_UP + I_DOWN;
            for (int it = gw; it < NITEMS; it += NGW) {
                int r = it;
                if (r < I_IN)   { transpose_item(w_in, DIN, 1024, 416, Wt + W_IN, 1, scr, r, lane); continue; } r -= I_IN;
                if (r < I_RETO) { transpose_item(w_reto, 1024, 2048, 32, Wt + W_RETO, 0, scr, r, lane); continue; } r -= I_RETO;
                if (r < I_SQ)   { transpose_item(w_diffo, 1024, 1024, 32, Wt + W_DIFFO, 0, scr, r, lane); continue; } r -= I_SQ;
                if (r < I_KV)   { transpose_item(w_kv, 2048, 1024, 64, Wt + W_KV, 0, scr, r, lane); continue; } r -= I_KV;
                if (r < I_SQ)   { transpose_item(w_crosso, 1024, 1024, 32, Wt + W_CROSSO, 0, scr, r, lane); continue; } r -= I_SQ;
                if (r < I_SQ)   { transpose_item(w_out, 1024, 1024, 32, Wt + W_OUT, 0, scr, r, lane); continue; } r -= I_SQ;
                if (r < I_UP)   { transpose_item(w_up, 4096, 1024, 128, Wt + W_UP, 0, scr, r, lane); continue; } r -= I_UP;
                transpose_item(w_down, 1024, 4096, 32, Wt + W_DOWN, 0, scr, r, lane);
            }
            const float* g_mem = AIN(12) + (size_t)l * DM; const float* g_mix = AIN(2) + (size_t)l * DM;
            for (int m = gw; m < MEMROWS; m += NGW) rms_row_bf16(mem + (size_t)m * DM, g_mem, MEMN + (size_t)m * DM, lane);
            for (int m = gw; m < MG; m += NGW) rms_row_bf16(xsrc + (size_t)m * DM, g_mix, H + (size_t)m * DM, lane);
        }
        PH_END;
        for (int group = 0; group < NGRP; ++group) {
            if (group > 0) {
                if (PH_ON && EN(1)) { PH_LOCALS; const float* xsrc = (l == 0) ? AIN(0) : out; bf16* H = WSB(WS_H); const float* g_mix = AIN(2) + (size_t)l * DM;
                    for (int m = gw; m < MG; m += NGW) rms_row_bf16(xsrc + (row0 + m) * DM, g_mix, H + (size_t)m * DM, lane); }
                PH_END;
            }
            if (PH_ON && EN(2)) { PH_LOCALS; (void)out; bf16 *H = WSB(WS_H), *MEMN = WSB(WS_MEMN), *MK = WSB(WS_MK), *MVT = WSB(WS_MVT);
                { pg8::Gemm g = pg8::gemm_plain(H, Wt + W_IN, DM); pg8::StaticOrder S; S.init(MG, NSEQ, G, bx);
                  pg8::EpiZseq E{WSB(WS_RQ), WSB(WS_RK), WSB(WS_RV), WSB(WS_DQ), WSB(WS_DK), WSB(WS_DV)};
                  pg8::gemm_phase<pg8::EpiZseq, pg8::StaticOrder, true, true>(lds + RING_OFF, g, S, E); }
                if (grp == 0) {
                    { pg8::Gemm g = pg8::gemm_plain(MEMN, Wt + W_KV, DM); pg8::StaticOrder S; S.init(MEMROWS, 1024, G, bx);
                      pg8::EpiBf16<0> E{MK, 1024};
                      pg8::gemm_phase<pg8::EpiBf16<0>, pg8::StaticOrder, true, true>(lds + RING_OFF, g, S, E); }
                    { pg8::Gemm g = pg8::gemm_plain(Wt + W_KV + (size_t)1024 * 1024, MEMN, DM); pg8::StaticOrder S; S.init(1024, MEMROWS, G, (bx + G - 32) % G);
                      pg8::EpiBf16<0> E{MVT, 2048};
                      pg8::gemm_phase<pg8::EpiBf16<0>, pg8::StaticOrder, true, true>(lds + RING_OFF, g, S, E); }
                }
            }
            PH_END;
            if (PH_ON && EN(3)) { PH_LOCALS; (void)out; (void)kal;
                if (bx < GB * 4 * 8) {
                    const int b = bx >> 5, hh = (bx >> 3) & 3, es = bx & 7;
                    const float lg = hh == 0 ? -0.04580368961312479f : hh == 1 ? -0.02272007650008353f : hh == 2 ? -0.011315313227834146f : -0.005646563141142063f;
                    ret::unit(lds + RING_OFF, WSB(WS_RQ) + (size_t)(b * 4 + hh) * SEQ * 256, WSB(WS_RK) + (size_t)(b * 4 + hh) * SEQ * 256, WSB(WS_RV) + (size_t)((b * 4 + hh) * 8 + es) * SEQ * 64,
                              WSB(WS_RETRAW) + (size_t)b * SEQ * 2048 + hh * 512 + es * 64, lg);
                }
                {
                    constexpr int NQB = SEQ / 256, NX = NQB / 2, TOTAL = GB * 4 * 2 * 2 * NX;
                    typedef da::BlockRef<bf16, bf16> BR;
                    const bf16 *DQ = WSB(WS_DQ), *DK = WSB(WS_DK), *DV = WSB(WS_DV); bf16* ODIFF = WSB(WS_ODIFF);
                    int L = bx;
                    if (L < TOTAL) {
                        int pass = 0; BR cur = da_ref(L, 0, DQ, DK, DV, ODIFF);
                        da::Seam<bf16> Sm;
                        da::causal_swa_prime<bf16, bf16>(cur, SEQ, (char*)lds_raw + RING_OFF, Sm);
                        for (;;) {
                            const bool more_pass = pass == 0, more_item = L + G < TOTAL, last = !more_pass && !more_item;
                            const int Ln = more_pass ? L : (more_item ? L + G : L), passn = more_pass ? 1 : 0;
                            const BR nxt = last ? cur : da_ref(Ln, passn, DQ, DK, DV, ODIFF);
                            const int hh = ((L / NX) >> 2) & 3;
                            const float bsl = (hh == 0 ? 0.25f : hh == 1 ? 0.0625f : hh == 2 ? 0.015625f : 0.00390625f) * 11.313708498984761f;
                            da::causal_swa_block<bf16, bf16>(cur, nxt, SEQ, SEQ, (char*)lds_raw + RING_OFF, Sm, bsl);
                            if (last) break;
                            cur = nxt; L = Ln; pass = passn;
                        }
                    }
                }
            }
            PH_END;
            if (PH_ON && EN(4)) { PH_LOCALS; (void)out; (void)kal; bf16* H = WSB(WS_H);
                pg8::Gemm g = pg8::gemm_plain(H, Wt + W_IN + (size_t)NSEQ * DM, DM); pg8::StaticOrder S; S.init(MG, NLOC, G, bx);
                pg8::EpiZloc E{WSB(WS_SRG), WSB(WS_CQ), WSB(WS_GATES)};
                pg8::gemm_phase<pg8::EpiZloc, pg8::StaticOrder, true, true>(lds + RING_OFF, g, S, E);
            }
            PH_END;
            if (PH_ON && EN(5)) { PH_LOCALS; (void)out; bf16 *RETRAW = WSB(WS_RETRAW), *SRG = WSB(WS_SRG), *ODIFF = WSB(WS_ODIFF), *DA = WSB(WS_DA), *CQ = WSB(WS_CQ), *MK = WSB(WS_MK), *PB = WSB(WS_P);
                const float* g_ret = AIN(4) + (size_t)l * 2048; const float* g_diff = AIN(10) + (size_t)l * 1024;
                const float* lq1 = AIN(6) + l * 128; const float* lk1 = AIN(7) + l * 128; const float* lq2 = AIN(8) + l * 128; const float* lk2 = AIN(9) + l * 128;
                const float s1 = wave_sum(lq1[lane] * lk1[lane] + lq1[lane + 64] * lk1[lane + 64]), s2 = wave_sum(lq2[lane] * lk2[lane] + lq2[lane + 64] * lk2[lane + 64]);
                const float lam_init = (l == 0) ? 0.2f : 0.35550906759096934f;
                const float lam = __expf(s1) - __expf(s2) + lam_init;
                for (int t = gw; t < MG * 4; t += NGW) { const int tok = t >> 2, hh = t & 3;
                    ret_norm_row(RETRAW + (size_t)tok * 2048 + hh * 512, SRG + (size_t)tok * 2048 + hh * 512, g_ret + hh * 512, lane); }
                for (int t = gw; t < MG * 4; t += NGW) { const int tok = t >> 2, hh = t & 3, b = tok >> 12, s = tok & 4095;
                    const bf16* o1 = ODIFF + ((size_t)((b * 4 + hh) * 2 + 0) * 2 * SEQ + s) * 128; const bf16* o2 = ODIFF + ((size_t)((b * 4 + hh) * 2 + 1) * 2 * SEQ + s) * 128;
                    diff_norm_row(o1, o2, (size_t)SEQ * 128, DA + (size_t)tok * 1024 + hh * 256, g_diff + hh * 256, lam, 1.0f - lam_init, lane); }
                if (G == 256) {
                    pg8::Gemm g; g.A = CQ; g.Bt = MK + (size_t)grp * GB * NMEM * 1024; g.K = 256; g.lda = 256; g.ldb = 1024; g.bsh = 4; g.a_pm = 256L * 256; g.a_pn = (long)MG * 256; g.b_pm = (long)NMEM * 1024; g.b_pn = 256;
                    pg8::StaticOrder S; S.init(MG, 1024, G, bx);
                    pg8::EpiSoftmax E{PB};
                    pg8::gemm_phase<pg8::EpiSoftmax, pg8::StaticOrder, false, true>(lds + RING_OFF, g, S, E);
                }
            }
            PH_END;
            if (PH_ON && EN(6)) { PH_LOCALS; (void)out; (void)kal; bf16 *PB = WSB(WS_P), *MVT = WSB(WS_MVT), *CA = WSB(WS_CA), *SRG = WSB(WS_SRG), *DA = WSB(WS_DA), *GATES = WSB(WS_GATES); float* MF = (float*)(GAS float*)(wsl + WS_MF);
                { pg8::Gemm g; g.A = PB; g.Bt = MVT + (size_t)grp * GB * NMEM; g.K = 256; g.lda = 256; g.ldb = 2048; g.bsh = 4; g.a_pm = 256L * 256; g.a_pn = (long)MG * 256; g.b_pm = NMEM; g.b_pn = 256L * 2048;
                  pg8::StaticOrder S; S.init(MG, 1024, G, bx);
                  pg8::EpiBf16<0> E{CA, 1024};
                  pg8::gemm_phase<pg8::EpiBf16<0>, pg8::StaticOrder, true, true>(lds + RING_OFF, g, S, E); }
                { pg8::Gemm g = pg8::gemm_plain(SRG, Wt + W_RETO, 2048); pg8::StaticOrder S; S.init(MG, 1024, G, bx);
                  pg8::EpiGateF32<true> E{MF, GATES, 0};
                  pg8::gemm_phase<pg8::EpiGateF32<true>, pg8::StaticOrder, true, true>(lds + RING_OFF, g, S, E); }
                { pg8::Gemm g = pg8::gemm_plain(DA, Wt + W_DIFFO, 1024); pg8::StaticOrder S; S.init(MG, 1024, G, bx);
                  pg8::EpiGateF32<false> E{MF, GATES, 1};
                  pg8::gemm_phase<pg8::EpiGateF32<false>, pg8::StaticOrder, true, true>(lds + RING_OFF, g, S, E); }
            }
            PH_END;
            if (PH_ON && EN(7)) { PH_LOCALS; (void)out; (void)kal; bf16 *CA = WSB(WS_CA), *MB = WSB(WS_MB), *GATES = WSB(WS_GATES); float* MF = (float*)(GAS float*)(wsl + WS_MF);
                pg8::Gemm g = pg8::gemm_plain(CA, Wt + W_CROSSO, 1024); pg8::StaticOrder S; S.init(MG, 1024, G, bx);
                pg8::EpiGateOut E{MF, MB, GATES, 2};
                pg8::gemm_phase<pg8::EpiGateOut, pg8::StaticOrder, true, true>(lds + RING_OFF, g, S, E);
            }
            PH_END;
            if (PH_ON && EN(8)) { PH_LOCALS; const float* xsrc = (l == 0) ? AIN(0) : out; bf16* MB = WSB(WS_MB);
                pg8::Gemm g = pg8::gemm_plain(MB, Wt + W_OUT, 1024); pg8::StaticOrder S; S.init(MG, 1024, G, bx);
                pg8::EpiRes E{xsrc + row0 * DM, out + row0 * DM};
                pg8::gemm_phase<pg8::EpiRes, pg8::StaticOrder, true, true>(lds + RING_OFF, g, S, E);
            }
            PH_END;
        }
        if (PH_ON && EN(9)) { PH_LOCALS_L; bf16* H2 = WSB(WS_H2); const float* g_ffn = AIN(16) + (size_t)l * DM;
            for (int m = gw; m < MALL; m += NGW) rms_row_bf16(out + (size_t)m * DM, g_ffn, H2 + (size_t)m * DM, lane); }
        PH_END;
        if (PH_ON && EN(10)) { PH_LOCALS_L; (void)l; (void)out; (void)kal; bf16 *H2 = WSB(WS_H2), *U = WSB(WS_U);
            pg8::Gemm g = pg8::gemm_plain(H2, Wt + W_UP, 1024); pg8::StaticOrder S; S.init(MALL, DFF, G, bx);
            pg8::EpiBf16<1> E{U, DFF};
            pg8::gemm_phase<pg8::EpiBf16<1>, pg8::StaticOrder, true, true>(lds + RING_OFF, g, S, E);
        }
        PH_END;
        if (PH_ON && EN(11)) { PH_LOCALS_L; (void)l; (void)kal; bf16* U = WSB(WS_U);
            pg8::Gemm g = pg8::gemm_plain(U, Wt + W_DOWN, DFF); pg8::StaticOrder S; S.init(MALL, 1024, G, bx);
            pg8::EpiRes E{out, out};
            pg8::gemm_phase<pg8::EpiRes, pg8::StaticOrder, true, true>(lds + RING_OFF, g, S, E);
        }
        PH_END;
    }
    if (PH_ON && EN(12)) { PH_LOCALS0; const float* g_final = AIN(19);
        for (int m = gw; m < MALL; m += NGW) rms_row_f32(out + (size_t)m * DM, g_final, lane);
#if MK_PER_PHASE && defined(DBG_CHECK)
        { const float Dd = __builtin_bit_cast(float, *((const unsigned*)(wsl + WS_CTL) + 2048)); VM_WAIT();
          for (int m = gw; m < MALL; m += NGW) { f32x4* xr = (f32x4*)(out + (size_t)m * DM) + lane; for (int j = 0; j < 4; ++j) xr[64 * j] = xr[64 * j] * (1.0f + Dd); } }
#endif
    }
#undef PH_ON
#undef PH_END
}


#if MK_PER_PHASE && defined(DBG_CHECK)
__device__ __forceinline__ float dbg_wave_max(float v) {
#pragma unroll
    for (int o = 1; o < 64; o <<= 1) v = fmaxf(v, __shfl_xor(v, o));
    return v;
}
__global__ void __launch_bounds__(64) dbg_check(unsigned char* ws, int which) {
    __shared__ float sc[4096]; __shared__ float qs[256];
    const int lane = threadIdx.x, smp = blockIdx.x;
    const int b = (smp & 1) * 2, h = (smp >> 1) & 3; const int tsel = smp >> 3; const int t = tsel == 0 ? 3 : tsel == 1 ? 70 : tsel == 2 ? 1000 : 4095;
    const bf16 *RQ = (const bf16*)(ws + WS_RQ), *RK = (const bf16*)(ws + WS_RK), *RV = (const bf16*)(ws + WS_RV), *DQ = (const bf16*)(ws + WS_DQ), *DK = (const bf16*)(ws + WS_DK), *DV = (const bf16*)(ws + WS_DV);
    const bf16 *RETRAW = (const bf16*)(ws + WS_RETRAW), *ODIFF = (const bf16*)(ws + WS_ODIFF);
    float num = 0.f, den = 0.f;
    if (which == 0) {
        const float slope = h == 0 ? 0.25f : h == 1 ? 0.0625f : h == 2 ? 0.015625f : 0.00390625f;
        for (int m = 0; m < 2; ++m) {
            const bf16* q = DQ + ((size_t)((b * 4 + h) * 2 + m) * SEQ + t) * 128; const bf16* K = DK + (size_t)((b * 4 + h) * 2 + m) * SEQ * 128;
            __syncthreads();
            for (int d = lane; d < 128; d += 64) qs[d] = bflo((unsigned)q[d]);
            __syncthreads();
            float mx = -3e38f;
            for (int j = lane; j <= t; j += 64) { float s = 0.f; for (int d = 0; d < 128; ++d) s += qs[d] * bflo((unsigned)K[(size_t)j * 128 + d]); s = s * 0.08838834764831845f - slope * (float)(t - j); sc[j] = s; mx = fmaxf(mx, s); }
            mx = dbg_wave_max(mx); float sum = 0.f;
            for (int j = lane; j <= t; j += 64) { const float p = __expf(sc[j] - mx); sc[j] = p; sum += p; }
            sum = wave_sum(sum);
            __syncthreads();
            const int half = lane >> 5, c = (lane & 31) * 4; const bf16* V = DV + (size_t)((b * 4 + h) * 2 + half) * SEQ * 128;
            float o[4] = {0.f, 0.f, 0.f, 0.f};
            for (int j = 0; j <= t; ++j) { const float p = sc[j]; for (int k = 0; k < 4; ++k) o[k] += p * bflo((unsigned)V[(size_t)j * 128 + c + k]); }
            const bf16* F = ODIFF + ((size_t)(((b * 4 + h) * 2 + m) * 2 + half) * SEQ + t) * 128 + c;
            for (int k = 0; k < 4; ++k) { const float r = o[k] / sum, f = bflo((unsigned)F[k]); num += (f - r) * (f - r); den += r * r; }
        }
    } else {
        const float lg = h == 0 ? -0.04580368961312479f : h == 1 ? -0.02272007650008353f : h == 2 ? -0.011315313227834146f : -0.005646563141142063f;
        const bf16* q = RQ + ((size_t)(b * 4 + h) * SEQ + t) * 256; const bf16* K = RK + (size_t)(b * 4 + h) * SEQ * 256;
        for (int d = lane; d < 256; d += 64) qs[d] = bflo((unsigned)q[d]);
        __syncthreads();
        for (int j = lane; j <= t; j += 64) { float s = 0.f; for (int d = 0; d < 256; ++d) s += qs[d] * bflo((unsigned)K[(size_t)j * 256 + d]); sc[j] = s * exp2f(lg * (float)(t - j)); }
        __syncthreads();
        float o[8] = {0.f, 0.f, 0.f, 0.f, 0.f, 0.f, 0.f, 0.f}; const int e0 = lane * 8, es = e0 >> 6, ec = e0 & 63;
        const bf16* V = RV + (size_t)((b * 4 + h) * 8 + es) * SEQ * 64 + ec;
        for (int j = 0; j <= t; ++j) { const float w = sc[j]; for (int k = 0; k < 8; ++k) o[k] += w * bflo((unsigned)V[(size_t)j * 64 + k]); }
        const bf16* F = RETRAW + ((size_t)b * SEQ + t) * 2048 + h * 512 + e0;
        for (int k = 0; k < 8; ++k) { const float f = bflo((unsigned)F[k]); num += (f - o[k]) * (f - o[k]); den += o[k] * o[k]; }
    }
    num = wave_sum(num); den = wave_sum(den);
    if (lane == 0) { const float D = sqrtf(num / fmaxf(den, 1e-30f)); atomicMax((unsigned*)(ws + WS_CTL) + 2048, __builtin_bit_cast(unsigned, D)); }
}
#endif

extern "C" void kernel_launch(void* const* d_in, const int* in_sizes, int n_in, void* d_out, int out_size, void* d_ws, size_t ws_size, hipStream_t stream) {
    static int grid = 0;
    if (grid == 0) {
        if (n_in != 20 || in_sizes[0] != MALL * DM || out_size != MALL * DM || ws_size < WS_END) {
            fprintf(stderr, "kernel_launch: built for 20 inputs, x/out of %d floats, >= %zu bytes of workspace; got n_in %d, in0 %d, out %d, ws %zu; nothing launched\n", MALL * DM, (size_t)WS_END, n_in, n_in > 0 ? in_sizes[0] : -1, out_size, ws_size); grid = -1; return; }
        int dev = 0, cus = 0, per_cu = 0;
        if (hipGetDevice(&dev) != hipSuccess || hipDeviceGetAttribute(&cus, hipDeviceAttributeMultiprocessorCount, dev) != hipSuccess) { fprintf(stderr, "kernel_launch: device query failed\n"); grid = -1; return; }
        if (hipFuncSetAttribute((const void*)fwd_kernel, hipFuncAttributeMaxDynamicSharedMemorySize, LDS_BYTES) != hipSuccess) { fprintf(stderr, "kernel_launch: hipFuncSetAttribute failed\n"); grid = -1; return; }
        if (hipOccupancyMaxActiveBlocksPerMultiprocessor(&per_cu, (const void*)fwd_kernel, NWAVES * 64, LDS_BYTES) != hipSuccess || per_cu < 1)
            fprintf(stderr, "kernel_launch: note: occupancy query reports %d workgroups per CU\n", per_cu);
        (void)hipGetLastError();
        grid = cus < 256 ? cus : 256;
        if (grid != 256) fprintf(stderr, "kernel_launch: %d CUs; this kernel is built for a 256-workgroup grid\n", cus);
    }
    if (grid < 0) return;
    if (hipMemsetAsync((char*)d_ws + WS_CTL, 0, CTL_ZERO_BYTES, stream) != hipSuccess) { fprintf(stderr, "kernel_launch: memset failed\n"); return; }
    Args a{};
    for (int i = 0; i < 20; ++i) a.in[i] = (const float*)d_in[i];
    a.out = (float*)d_out; a.ws = (unsigned char*)d_ws;
#if MK_PER_PHASE
    for (int p = 0; p < NPHASE; ++p) { a.ph_lo = p; a.ph_hi = p + 1; hipLaunchKernelGGL(fwd_kernel, dim3(grid), dim3(NWAVES * 64), LDS_BYTES, stream, a);
#if defined(DBG_CHECK)
        if (p == 2) hipLaunchKernelGGL(dbg_check, dim3(32), dim3(64), 0, stream, (unsigned char*)d_ws, (int)DBG_CHECK - 1);
#endif
    }
#else
    a.ph_lo = 0; a.ph_hi = NPHASE;
    hipLaunchKernelGGL(fwd_kernel, dim3(grid), dim3(NWAVES * 64), LDS_BYTES, stream, a);
#endif
    const hipError_t le = hipPeekAtLastError();
    if (le != hipSuccess) fprintf(stderr, "kernel_launch: launch failed: %s\n", hipGetErrorName(le));
}
```
